# Optimizing an MI355X kernel written in HIP

```python
import jax, jax.numpy as jnp
from jax import lax
import numpy as np

D_MODEL = 1024
BATCH = 16
SEQ = 2048
DEPTH = 1
DEC_BATCH = 4
DEC_SEQ = 8192
PAST_LEN = 128

N_HEADS = 16
N_KV_HEADS = 4
HEAD_DIM = 64
ATTN_WIDTH = N_HEADS * HEAD_DIM
KV_WIDTH = N_KV_HEADS * HEAD_DIM
WINDOW = 128
BLOCK = 128
ROPE_THETA = 10000.0
POOL_WIDTH = D_MODEL
POOL_WINDOWS = (2, 4, 8, 16)
N_POOL_GROUPS = 4
POOL_GROUP = POOL_WIDTH // N_POOL_GROUPS
N_BRANCHES = 2
RMS_EPS = 1e-6
NEG_INF = -1e30
IN_WIDTH = 2 * POOL_WIDTH + 2 * ATTN_WIDTH + 2 * KV_WIDTH + N_BRANCHES * D_MODEL

kernel_name = "hybrid_pool_swa_gated_encoder"


def rmsnorm(x, g):
    xf = x.astype(jnp.float32)
    y = xf * lax.rsqrt(jnp.mean(xf * xf, axis=-1, keepdims=True) + RMS_EPS) * g.astype(jnp.float32)
    return y.astype(x.dtype)


def rope(x, pos):
    half = HEAD_DIM // 2
    inv = ROPE_THETA ** (-jnp.arange(half, dtype=jnp.float32) / half)
    ang = pos.astype(jnp.float32)[:, None] * inv[None, :]
    cos = jnp.cos(ang)[None, :, None, :]
    sin = jnp.sin(ang)[None, :, None, :]
    xf = x.astype(jnp.float32)
    x1, x2 = xf[..., :half], xf[..., half:]
    out = jnp.concatenate([x1 * cos - x2 * sin, x2 * cos + x1 * sin], axis=-1)
    return out.astype(x.dtype)


def multiscale_pool(u):
    B, S, _ = u.shape
    uf = u.astype(jnp.float32).reshape(B, S, N_POOL_GROUPS, POOL_GROUP)
    c = jnp.concatenate([jnp.zeros((B, 1, N_POOL_GROUPS, POOL_GROUP), jnp.float32),
                         jnp.cumsum(uf, axis=1)], axis=1)
    t = jnp.arange(S)
    outs = []
    for g, w in enumerate(POOL_WINDOWS):
        lo = jnp.clip(t - w // 2, 0, S)
        hi = jnp.clip(t - w // 2 + w, 0, S)
        cg = c[:, :, g]
        mean = (cg[:, hi] - cg[:, lo]) / (hi - lo).astype(jnp.float32)[None, :, None]
        outs.append(mean)
    return jnp.stack(outs, axis=2) - uf


def windowed_attention(q, k, v, sink):
    B, S = q.shape[0], q.shape[1]
    nb = S // BLOCK
    G = N_HEADS // N_KV_HEADS
    span = BLOCK + 2 * WINDOW
    qg = jnp.moveaxis(q.reshape(B, nb, BLOCK, N_KV_HEADS, G, HEAD_DIM), 1, 0)
    pad = ((0, 0), (WINDOW, WINDOW), (0, 0), (0, 0))
    kp = jnp.pad(k, pad)
    vp = jnp.pad(v, pad)
    rel = jnp.arange(BLOCK)[:, None] - (jnp.arange(span)[None, :] - WINDOW)
    band = jnp.abs(rel) <= WINDOW
    scale = HEAD_DIM ** -0.5
    sink_b = sink.astype(jnp.float32).reshape(1, N_KV_HEADS, G, 1, 1)

    def one_block(args):
        qb, i = args
        start = i * BLOCK
        kb = lax.dynamic_slice_in_dim(kp, start, span, axis=1)
        vb = lax.dynamic_slice_in_dim(vp, start, span, axis=1)
        kpos = start - WINDOW + jnp.arange(span)
        valid = band & ((kpos >= 0) & (kpos < S))[None, :]
        s = jnp.einsum('bqhgd,bkhd->bhgqk', qb, kb).astype(jnp.float32) * scale
        s = jnp.where(valid, s, NEG_INF)
        logits = jnp.concatenate([s, jnp.broadcast_to(sink_b, s.shape[:-1] + (1,))], axis=-1)
        p = jax.nn.softmax(logits, axis=-1)[..., :span]
        return jnp.einsum('bhgqk,bkhd->bqhgd', p.astype(vb.dtype), vb)

    o = lax.map(one_block, (qg, jnp.arange(nb)))
    return jnp.moveaxis(o, 0, 1).reshape(B, S, ATTN_WIDTH)


def encoder_layer(x, norm_pre, w_in, w_pool_group, pool_scale, w_pool_proj,
                  attn_sink, w_attn_proj, w_out, norm_post):
    B, S, _ = x.shape
    h = rmsnorm(x, norm_pre)
    z = h @ w_in
    cuts = np.cumsum([POOL_WIDTH, POOL_WIDTH, ATTN_WIDTH, KV_WIDTH, KV_WIDTH, ATTN_WIDTH]).tolist()
    pool_u, pool_g, q, k, v, attn_g, merge = jnp.split(z, cuts, axis=-1)

    pooled = multiscale_pool(pool_u).astype(x.dtype)
    pb = jnp.einsum('bsgc,gcd->bsgd', pooled, w_pool_group).reshape(B, S, POOL_WIDTH)
    pb = pb * pool_scale * jax.nn.silu(pool_g)

    pos = jnp.arange(S)
    q = rope(q.reshape(B, S, N_HEADS, HEAD_DIM), pos)
    k = rope(k.reshape(B, S, N_KV_HEADS, HEAD_DIM), pos)
    v = v.reshape(B, S, N_KV_HEADS, HEAD_DIM)
    ab = windowed_attention(q, k, v, attn_sink) * jax.nn.silu(attn_g)

    gates = jax.nn.sigmoid(merge.astype(jnp.float32)).astype(x.dtype)
    gate_pool, gate_attn = gates[..., :D_MODEL], gates[..., D_MODEL:]
    m = gate_pool * (pb @ w_pool_proj) + gate_attn * (ab @ w_attn_proj)
    out = m @ w_out
    return x + rmsnorm(out, norm_post)


def setup_inputs(seed: int = 0) -> dict:
    key = jax.random.key(seed)
    ks = jax.random.split(key, 12)
    f32 = jnp.float32
    nrm = lambda k, shape, s: jax.random.normal(k, shape, f32) * s
    return {
        "x_prompt": nrm(ks[0], (BATCH, SEQ, D_MODEL), 1.0),
        "x_sample": nrm(ks[1], (DEC_BATCH, DEC_SEQ, D_MODEL), 1.0),
        "norm_pre": 1.0 + nrm(ks[2], (DEPTH, D_MODEL), 0.05),
        "w_in": nrm(ks[3], (DEPTH, D_MODEL, IN_WIDTH), D_MODEL ** -0.5),
        "w_pool_group": nrm(ks[4], (DEPTH, N_POOL_GROUPS, POOL_GROUP, POOL_GROUP), POOL_GROUP ** -0.5),
        "pool_scale": 1.0 + nrm(ks[5], (DEPTH, POOL_WIDTH), 0.1),
        "w_pool_proj": nrm(ks[6], (DEPTH, POOL_WIDTH, D_MODEL), POOL_WIDTH ** -0.5),
        "attn_sink": nrm(ks[7], (DEPTH, N_HEADS), 1.0),
        "w_attn_proj": nrm(ks[8], (DEPTH, ATTN_WIDTH, D_MODEL), ATTN_WIDTH ** -0.5),
        "w_out": nrm(ks[9], (DEPTH, D_MODEL, D_MODEL), D_MODEL ** -0.5),
        "norm_post": 1.0 + nrm(ks[10], (DEPTH, D_MODEL), 0.05),
    }


def reference(x_prompt, x_sample, norm_pre, w_in, w_pool_group, pool_scale, w_pool_proj,
              attn_sink, w_attn_proj, w_out, norm_post):
    y_prompt = x_prompt
    y_sample = x_sample
    for l in range(DEPTH):
        y_prompt = encoder_layer(y_prompt, norm_pre[l], w_in[l], w_pool_group[l], pool_scale[l],
                                 w_pool_proj[l], attn_sink[l], w_attn_proj[l], w_out[l], norm_post[l])
        y_sample = encoder_layer(y_sample, norm_pre[l], w_in[l], w_pool_group[l], pool_scale[l],
                                 w_pool_proj[l], attn_sink[l], w_attn_proj[l], w_out[l], norm_post[l])
    return (y_prompt, y_sample)
```

```cpp
#include <hip/hip_runtime.h>
#include <cstdio>
#include <cstdint>

constexpr int D = 1024, INW = 6656, NH = 16, NKV = 4, HD = 64;
constexpr int CH = 16384;
constexpr int OFF_U = 0, OFF_PG = 1024, OFF_Q = 2048, OFF_K = 3072, OFF_V = 3328, OFF_AG = 3584, OFF_MG = 4608;
constexpr float EPS = 1e-6f;

__device__ __forceinline__ float wave_sum(float v) {
#pragma unroll
    for (int o = 1; o < 64; o <<= 1) v += __shfl_xor(v, o);
    return v;
}
__device__ __forceinline__ float siluf(float v) { return v / (1.f + expf(-v)); }
__device__ __forceinline__ float sigmf(float v) { return 1.f / (1.f + expf(-v)); }

__global__ __launch_bounds__(256) void k_rms_h(const float* __restrict__ x, const float* __restrict__ g, float* __restrict__ h, int rows) {
    const int lane = threadIdx.x & 63, row = blockIdx.x * 4 + (threadIdx.x >> 6);
    if (row >= rows) return;
    const float4* xr = (const float4*)(x + (size_t)row * D);
    float4 v[4]; float s = 0.f;
#pragma unroll
    for (int j = 0; j < 4; ++j) { v[j] = xr[lane + 64 * j]; s += v[j].x * v[j].x + v[j].y * v[j].y + v[j].z * v[j].z + v[j].w * v[j].w; }
    const float r = 1.0f / sqrtf(wave_sum(s) * (1.f / D) + EPS);
    float4* hr = (float4*)(h + (size_t)row * D);
#pragma unroll
    for (int j = 0; j < 4; ++j) { const float4 gg = ((const float4*)g)[lane + 64 * j]; float4 o; o.x = v[j].x * r * gg.x; o.y = v[j].y * r * gg.y; o.z = v[j].z * r * gg.z; o.w = v[j].w * r * gg.w; hr[lane + 64 * j] = o; }
}

__global__ __launch_bounds__(256) void k_final(const float* __restrict__ x, const float* __restrict__ o_, const float* __restrict__ g, float* __restrict__ y, int rows) {
    const int lane = threadIdx.x & 63, row = blockIdx.x * 4 + (threadIdx.x >> 6);
    if (row >= rows) return;
    const float4* orow = (const float4*)(o_ + (size_t)row * D);
    float4 v[4]; float s = 0.f;
#pragma unroll
    for (int j = 0; j < 4; ++j) { v[j] = orow[lane + 64 * j]; s += v[j].x * v[j].x + v[j].y * v[j].y + v[j].z * v[j].z + v[j].w * v[j].w; }
    const float r = 1.0f / sqrtf(wave_sum(s) * (1.f / D) + EPS);
    const float4* xr = (const float4*)(x + (size_t)row * D);
    float4* yr = (float4*)(y + (size_t)row * D);
#pragma unroll
    for (int j = 0; j < 4; ++j) { const float4 gg = ((const float4*)g)[lane + 64 * j]; const float4 xx = xr[lane + 64 * j]; float4 o; o.x = xx.x + v[j].x * r * gg.x; o.y = xx.y + v[j].y * r * gg.y; o.z = xx.z + v[j].z * r * gg.z; o.w = xx.w + v[j].w * r * gg.w; yr[lane + 64 * j] = o; }
}

struct EpiStore { float* C; int ldc; int pad; __device__ __forceinline__ void operator()(int r, int c, float v) const { C[(size_t)r * ldc + c] = v; } };
struct EpiPB { float* Z; const float* scale; int coff; int pad; __device__ __forceinline__ void operator()(int r, int c, float v) const {
    float* zr = Z + (size_t)r * INW; const int cc = coff + c; zr[OFF_U + cc] = v * scale[cc] * siluf(zr[OFF_PG + cc]); } };
struct EpiGate { float* Mo; const float* Z; int ldm; int goff; int accum; int pad; __device__ __forceinline__ void operator()(int r, int c, float v) const {
    const float gte = sigmf(Z[(size_t)r * INW + goff + c]); float* p = Mo + (size_t)r * ldm + c; const float val = gte * v; *p = accum ? (*p + val) : val; } };

template <class Epi>
__global__ __launch_bounds__(256) void k_gemm(const float* __restrict__ A, int lda, const float* __restrict__ B, int ldb, int K, Epi epi) {
    __shared__ float As[16][132];
    __shared__ float Bs[16][132];
    const int bm = blockIdx.y * 128, bn = blockIdx.x * 128;
    const int tid = threadIdx.x, tx = tid & 15, ty = tid >> 4;
    float acc[8][8];
#pragma unroll
    for (int i = 0; i < 8; ++i)
#pragma unroll
        for (int j = 0; j < 8; ++j) acc[i][j] = 0.f;
    for (int k0 = 0; k0 < K; k0 += 16) {
        {   const int r = tid >> 1, c = (tid & 1) * 8; const float4* p = (const float4*)(A + (size_t)(bm + r) * lda + k0 + c); const float4 v0 = p[0], v1 = p[1];
            As[c + 0][r] = v0.x; As[c + 1][r] = v0.y; As[c + 2][r] = v0.z; As[c + 3][r] = v0.w; As[c + 4][r] = v1.x; As[c + 5][r] = v1.y; As[c + 6][r] = v1.z; As[c + 7][r] = v1.w; }
        {   const int r = tid >> 4, c = (tid & 15) * 8; const float4* p = (const float4*)(B + (size_t)(k0 + r) * ldb + bn + c); const float4 v0 = p[0], v1 = p[1];
            *(float4*)&Bs[r][c] = v0; *(float4*)&Bs[r][c + 4] = v1; }
        __syncthreads();
#pragma unroll
        for (int k = 0; k < 16; ++k) {
            const float4 a0 = *(const float4*)&As[k][ty * 8], a1 = *(const float4*)&As[k][ty * 8 + 4];
            const float4 b0 = *(const float4*)&Bs[k][tx * 8], b1 = *(const float4*)&Bs[k][tx * 8 + 4];
            const float a[8] = {a0.x, a0.y, a0.z, a0.w, a1.x, a1.y, a1.z, a1.w};
            const float b[8] = {b0.x, b0.y, b0.z, b0.w, b1.x, b1.y, b1.z, b1.w};
#pragma unroll
            for (int i = 0; i < 8; ++i)
#pragma unroll
                for (int j = 0; j < 8; ++j) acc[i][j] = fmaf(a[i], b[j], acc[i][j]);
        }
        __syncthreads();
    }
#pragma unroll
    for (int i = 0; i < 8; ++i)
#pragma unroll
        for (int j = 0; j < 8; ++j) epi(bm + ty * 8 + i, bn + tx * 8 + j, acc[i][j]);
}

__global__ __launch_bounds__(256) void k_rope(float* __restrict__ Z, int S, int ntok) {
    const long idx = (long)blockIdx.x * 256 + threadIdx.x;
    const int i = (int)(idx & 31); const long r = idx >> 5; const int hh = (int)(r % 20); const long tok = r / 20;
    if (tok >= ntok) return;
    const int pos = (int)(tok % S);
    const float inv = (float)pow(10000.0, -(double)i / 32.0);
    const float ang = (float)pos * inv;
    const float cs = (float)cos((double)ang), sn = (float)sin((double)ang);
    float* p = Z + (size_t)tok * INW + (hh < 16 ? OFF_Q + hh * 64 : OFF_K + (hh - 16) * 64);
    const float x1 = p[i], x2 = p[i + 32];
    p[i] = x1 * cs - x2 * sn; p[i + 32] = x2 * cs + x1 * sn;
}

__global__ __launch_bounds__(256) void k_pool(const float* __restrict__ Z, float* __restrict__ P, int S, int ntok) {
    const long idx = (long)blockIdx.x * 256 + threadIdx.x;
    const int c = (int)(idx & 1023); const long tok = idx >> 10;
    if (tok >= ntok) return;
    const int pos = (int)(tok % S); const long sb = tok - pos;
    const int g = c >> 8, w = 2 << g;
    int lo = pos - w / 2, hi = pos - w / 2 + w; lo = lo < 0 ? 0 : lo; hi = hi > S ? S : hi;
    float s = 0.f;
    for (int j = lo; j < hi; ++j) s += Z[(size_t)(sb + j) * INW + OFF_U + c];
    P[(size_t)tok * D + c] = s / (float)(hi - lo) - Z[(size_t)tok * INW + OFF_U + c];
}

__global__ __launch_bounds__(256) void k_attn(float* __restrict__ Z, const float* __restrict__ sink, int S, int ntok) {
    const long idx = (long)blockIdx.x * 256 + threadIdx.x;
    const int h = (int)(idx & 15); const long tok = idx >> 4;
    if (tok >= ntok) return;
    const int pos = (int)(tok % S); const long sb = tok - pos; const int hkv = h >> 2;
    float q[64], o[64];
    float* qp = Z + (size_t)tok * INW + OFF_Q + h * 64;
#pragma unroll
    for (int d = 0; d < 64; d += 4) { const float4 v = *(const float4*)(qp + d); q[d] = v.x; q[d + 1] = v.y; q[d + 2] = v.z; q[d + 3] = v.w; }
#pragma unroll
    for (int d = 0; d < 64; ++d) o[d] = 0.f;
    float m = sink[h], l = 1.f;
    int lo = pos - 128, hi = pos + 128; lo = lo < 0 ? 0 : lo; hi = hi > S - 1 ? S - 1 : hi;
    for (int j = lo; j <= hi; ++j) {
        const float* kp = Z + (size_t)(sb + j) * INW + OFF_K + hkv * 64;
        const float* vp = Z + (size_t)(sb + j) * INW + OFF_V + hkv * 64;
        float s = 0.f;
#pragma unroll
        for (int d = 0; d < 64; d += 4) { const float4 kv = *(const float4*)(kp + d); s += q[d] * kv.x + q[d + 1] * kv.y + q[d + 2] * kv.z + q[d + 3] * kv.w; }
        s *= 0.125f;
        const float mn = fmaxf(m, s), al = expf(m - mn), p = expf(s - mn);
        l = l * al + p; m = mn;
#pragma unroll
        for (int d = 0; d < 64; d += 4) { const float4 vv = *(const float4*)(vp + d); o[d] = o[d] * al + p * vv.x; o[d + 1] = o[d + 1] * al + p * vv.y; o[d + 2] = o[d + 2] * al + p * vv.z; o[d + 3] = o[d + 3] * al + p * vv.w; }
    }
    const float il = 1.f / l;
    const float* gp = Z + (size_t)tok * INW + OFF_AG + h * 64;
#pragma unroll
    for (int d = 0; d < 64; d += 4) { const float4 gg = *(const float4*)(gp + d); float4 r; r.x = o[d] * il * siluf(gg.x); r.y = o[d + 1] * il * siluf(gg.y); r.z = o[d + 2] * il * siluf(gg.z); r.w = o[d + 3] * il * siluf(gg.w); *(float4*)(qp + d) = r; }
}

extern "C" void kernel_launch(void* const* d_in, const int* in_sizes, int n_in, void* d_out, int out_size, void* d_ws, size_t ws_size, hipStream_t stream) {
    const float* x_prompt = (const float*)d_in[0]; const float* x_sample = (const float*)d_in[1];
    const float* norm_pre = (const float*)d_in[2]; const float* w_in = (const float*)d_in[3]; const float* w_pg = (const float*)d_in[4];
    const float* pool_scale = (const float*)d_in[5]; const float* w_pp = (const float*)d_in[6]; const float* sink = (const float*)d_in[7];
    const float* w_ap = (const float*)d_in[8]; const float* w_out = (const float*)d_in[9]; const float* norm_post = (const float*)d_in[10];
    float* out = (float*)d_out;
    float* H = (float*)d_ws;
    float* Z = H + (size_t)CH * D;
    if (ws_size < ((size_t)CH * D + (size_t)CH * INW) * 4) { fprintf(stderr, "ws too small\n"); return; }
    for (int c = 0; c < 4; ++c) {
        const float* x = c < 2 ? x_prompt + (size_t)c * CH * D : x_sample + (size_t)(c - 2) * CH * D;
        float* y = out + (size_t)c * CH * D;
        const int S = c < 2 ? 2048 : 8192;
        k_rms_h<<<CH / 4, 256, 0, stream>>>(x, norm_pre, H, CH);
        k_gemm<EpiStore><<<dim3(INW / 128, CH / 128), 256, 0, stream>>>(H, D, w_in, INW, D, EpiStore{Z, INW, 0});
        k_rope<<<(int)(((long)CH * 20 * 32) / 256), 256, 0, stream>>>(Z, S, CH);
        k_pool<<<(int)(((long)CH * 1024) / 256), 256, 0, stream>>>(Z, H, S, CH);
        for (int g = 0; g < 4; ++g)
            k_gemm<EpiPB><<<dim3(256 / 128, CH / 128), 256, 0, stream>>>(H + g * 256, D, w_pg + (size_t)g * 256 * 256, 256, 256, EpiPB{Z, pool_scale, g * 256, 0});
        k_attn<<<(int)(((long)CH * 16) / 256), 256, 0, stream>>>(Z, sink, S, CH);
        k_gemm<EpiGate><<<dim3(D / 128, CH / 128), 256, 0, stream>>>(Z + OFF_U, INW, w_pp, D, D, EpiGate{Z + OFF_PG, Z, INW, OFF_MG, 0, 0});
        k_gemm<EpiGate><<<dim3(D / 128, CH / 128), 256, 0, stream>>>(Z + OFF_Q, INW, w_ap, D, D, EpiGate{Z + OFF_PG, Z, INW, OFF_MG + 1024, 1, 0});
        k_gemm<EpiStore><<<dim3(D / 128, CH / 128), 256, 0, stream>>>(Z + OFF_PG, INW, w_out, D, D, EpiStore{H, D, 0});
        k_final<<<CH / 4, 256, 0, stream>>>(x, H, norm_post, y, CH);
    }
}
```

```cpp
#include <hip/hip_runtime.h>
#include <cstdio>
#include <cstdint>

#define LAS __attribute__((address_space(3)))
#define GAS __attribute__((address_space(1)))
typedef unsigned short bf16_t;
typedef short bf16x8 __attribute__((ext_vector_type(8)));
typedef short s16x4 __attribute__((ext_vector_type(4)));
typedef float f32x4 __attribute__((ext_vector_type(4)));
typedef float f32x16 __attribute__((ext_vector_type(16)));
typedef unsigned u32x4 __attribute__((ext_vector_type(4)));
typedef unsigned u32x2 __attribute__((ext_vector_type(2)));
typedef float f32x2_t __attribute__((ext_vector_type(2)));
typedef __bf16 bf16x2_t __attribute__((ext_vector_type(2)));

constexpr int DM = 1024, INW = 6656, NTOK = 65536, CHT = 32768  , NCHUNK = 2;
constexpr float RMS_EPS = 1e-6f;
constexpr float LOG2E = 1.4426950408889634f;
constexpr float QSCALE = 0.125f * LOG2E;

__device__ __forceinline__ unsigned cvtpk(float lo, float hi) { f32x2_t v = {lo, hi}; bf16x2_t b = __builtin_convertvector(v, bf16x2_t); return __builtin_bit_cast(unsigned, b); }
__device__ __forceinline__ float bf_lo(unsigned u) { return __uint_as_float(u << 16); }
__device__ __forceinline__ float bf_hi(unsigned u) { return __uint_as_float(u & 0xffff0000u); }
__device__ __forceinline__ float fexp(float x) { return __builtin_amdgcn_exp2f(x * LOG2E); }
__device__ __forceinline__ float silu_f(float v) { return v * __builtin_amdgcn_rcpf(1.f + fexp(-v)); }

namespace pg8 {
constexpr int BM = 256, BK = 64, HALF = 128, HTB = HALF * BK * 2, STAGE_BYTES = 8 * HTB, NXCD = 8, WGM = 8;
__host__ __device__ __forceinline__ int lds_byte(int r, int c) { const int st = (r >> 4) * 2 + (c >> 5), rr = r & 15, cc = c & 31, ob = rr * 64 + cc * 2; return st * 1024 + (ob ^ (((ob >> 9) & 1) << 5)); }
__host__ __device__ __forceinline__ void stage_rc(int b, int& R, int& C) { const int st = b / 1024, sb = b % 1024, swz = sb ^ (((sb >> 9) & 1) << 5); R = (st >> 1) * 16 + swz / 64; C = (st & 1) * 32 + (swz % 64) / 2; }
__host__ __device__ __forceinline__ int perm32(int rho) { const int n = rho >> 4, i = rho & 15; return 8 * (i >> 2) + 4 * n + (i & 3); }

struct Unit { int pm, pn; };
struct Gemm { const bf16_t* A; const bf16_t* Bt; int lda, ldb, K, a_pn_step; };

struct StaticOrder {
    int nM, nN, nwg, G, c;
    __device__ void init(int M, int N, int G_, int c_) { nM = M / BM; nN = N / BM; nwg = nM * nN; G = G_; c = c_; }
    __device__ bool next(int i, Unit& u) const {
        const long L = (long)i * G + c; if (L >= nwg) return false;
        int wgid = (int)L; { const int q = nwg / NXCD, r = nwg % NXCD, xcd = wgid % NXCD, off = wgid / NXCD; wgid = (xcd < r ? xcd * (q + 1) : r * (q + 1) + (xcd - r) * q) + off; }
        const int nig = WGM * nN, gid = wgid / nig, fm = gid * WGM, gsz = (nM - fm) < WGM ? (nM - fm) : WGM;
        u.pm = fm + ((wgid % nig) % gsz); u.pn = (wgid % nig) / gsz; return true;
    }
};

template <class Epi, class Sched, bool ALIGN_EPI, bool SP2>
__device__ __forceinline__ void gemm_phase(LAS unsigned char* lds, const Gemm g, const Sched& S, const Epi& E) {
    int tid_ = threadIdx.x; asm volatile("" : "+v"(tid_));
    const int tid = tid_, wid = __builtin_amdgcn_readfirstlane(tid >> 6), lane = tid & 63, wr = wid >> 2, wc = wid & 3, fr = lane & 15, fq = lane >> 4;
    const int K = g.K, nt = K / BK;
    unsigned voffA[2], voffB[2];
#pragma unroll
    for (int i = 0; i < 2; ++i) { int R, C; stage_rc(tid * 16 + i * 8192, R, C); const int Rb = Epi::PERM ? ((R & ~31) + perm32(R & 31)) : R;
        voffA[i] = (unsigned)(R * g.lda + C) * 2u; voffB[i] = (unsigned)(Rb * g.ldb + C) * 2u; }
    const size_t kstep = (size_t)(BK * 2);
    const size_t hstepA = (size_t)HALF * g.lda * 2, hstepB = (size_t)HALF * g.ldb * 2;
    const size_t tstepA = 2 * hstepA, tstepB = 2 * hstepB, pnstepA = (size_t)g.a_pn_step * 2;
    const unsigned ldsw = (unsigned)wid * 1024u;
    const int aoff = lds_byte(wr * 64 + fr, fq * 8), boff = lds_byte(wc * 32 + fr, fq * 8);
#define PG8_SA(b, h) (((b) * 2 + (h)) * HTB)
#define PG8_SB(b, h) ((4 + (b) * 2 + (h)) * HTB)
#define PG8_STAGE(bufoff, gbase, voff) do { _Pragma("unroll") for (int _i = 0; _i < 2; ++_i) \
        __builtin_amdgcn_global_load_lds((const unsigned*)((const char*)(gbase) + (voff)[_i]), (LAS unsigned*)(lds + (bufoff) + ldsw + _i * 8192), 16, 0, 0); } while (0)
#define PG8_LDA(dst, b, h) do { _Pragma("unroll") for (int m = 0; m < 4; ++m) _Pragma("unroll") for (int k = 0; k < 2; ++k) dst[m][k] = *(const LAS bf16x8*)(lds + PG8_SA(b, h) + aoff + m * 2048 + k * 1024); } while (0)
#define PG8_LDB(dst, b, h) do { _Pragma("unroll") for (int n = 0; n < 2; ++n) _Pragma("unroll") for (int k = 0; k < 2; ++k) dst[n][k] = *(const LAS bf16x8*)(lds + PG8_SB(b, h) + boff + n * 2048 + k * 1024); } while (0)
#define PG8_MMA(ai, bj, At, Bt) do { __builtin_amdgcn_s_setprio(1); _Pragma("unroll") for (int m = 0; m < 4; ++m) _Pragma("unroll") for (int n = 0; n < 2; ++n) _Pragma("unroll") for (int k = 0; k < 2; ++k) \
        acc[ai][bj][m][n] = __builtin_amdgcn_mfma_f32_16x16x32_bf16(Bt[n][k], At[m][k], acc[ai][bj][m][n], 0, 0, 0); __builtin_amdgcn_s_setprio(0); } while (0)
#define PG8_WAIT_V(n) asm volatile("s_waitcnt vmcnt(" #n ")" ::: "memory")
#define PG8_WAIT_L(n) asm volatile("s_waitcnt lgkmcnt(" #n ")" ::: "memory")
#define PG8_BAR __builtin_amdgcn_s_barrier()
#define PG8_SCHED __builtin_amdgcn_sched_barrier(0)
    Unit cur, nxt; int ui = 0;
    if (!S.next(0, cur)) return;
    f32x4 acc[2][2][4][2];
#pragma unroll
    for (int a = 0; a < 2; ++a)
#pragma unroll
        for (int b = 0; b < 2; ++b)
#pragma unroll
            for (int m = 0; m < 4; ++m)
#pragma unroll
                for (int n = 0; n < 2; ++n) acc[a][b][m][n] = (f32x4){0.f, 0.f, 0.f, 0.f};
    bf16x8 At[4][2], B0[2][2], B1[2][2];
    const char* cA = (const char*)g.A + (size_t)cur.pm * tstepA + (size_t)cur.pn * pnstepA; const char* cB = (const char*)g.Bt + (size_t)cur.pn * tstepB;
    if constexpr (SP2) {
        PG8_STAGE(PG8_SB(0, 0), cB, voffB); PG8_STAGE(PG8_SB(0, 1), cB + hstepB, voffB); PG8_STAGE(PG8_SA(0, 0), cA, voffA); PG8_STAGE(PG8_SA(0, 1), cA + hstepA, voffA);
        if (wr == 1) PG8_BAR;
        PG8_WAIT_V(2); PG8_BAR;
        PG8_STAGE(PG8_SB(1, 0), cB + kstep, voffB); PG8_STAGE(PG8_SA(1, 0), cA + kstep, voffA); PG8_STAGE(PG8_SB(1, 1), cB + hstepB + kstep, voffB);
        PG8_WAIT_V(6); PG8_BAR;
    } else {
        PG8_STAGE(PG8_SB(0, 0), cB, voffB); PG8_STAGE(PG8_SA(0, 0), cA, voffA); PG8_STAGE(PG8_SB(0, 1), cB + hstepB, voffB); PG8_STAGE(PG8_SA(0, 1), cA + hstepA, voffA);
        if (wr == 1) PG8_BAR;
        PG8_WAIT_V(4); PG8_BAR;
        PG8_STAGE(PG8_SB(1, 0), cB + kstep, voffB); PG8_STAGE(PG8_SA(1, 0), cA + kstep, voffA); PG8_STAGE(PG8_SB(1, 1), cB + hstepB + kstep, voffB);
        PG8_WAIT_V(6); PG8_BAR;
    }
    for (;;) {
        const bool has_next = S.next(ui + 1, nxt);
        const char* nA = has_next ? (const char*)g.A + (size_t)nxt.pm * tstepA + (size_t)nxt.pn * pnstepA : cA; const char* nB = has_next ? (const char*)g.Bt + (size_t)nxt.pn * tstepB : cB;
        for (int t = 0; t < nt; t += 2) {
            if constexpr (Epi::HAS_MID) { if (t == (nt >> 1)) E.mid(acc, cur, wr, wc, fr, fq); }
            const bool last = (t == nt - 2);
            const char* a1 = cA + (size_t)(t + 1) * kstep;
            const char* a2 = last ? nA : cA + (size_t)(t + 2) * kstep; const char* b2 = last ? nB : cB + (size_t)(t + 2) * kstep;
            const char* a3 = a2 + kstep; const char* b3 = b2 + kstep;
            if constexpr (SP2) {
            PG8_LDB(B0, 0, 0); PG8_LDB(B1, 0, 1); PG8_SCHED; PG8_LDA(At, 0, 0); PG8_STAGE(PG8_SA(1, 1), a1 + hstepA, voffA);
            PG8_WAIT_V(8); PG8_WAIT_L(0); PG8_BAR; PG8_MMA(0, 0, At, B0); PG8_MMA(0, 1, At, B1); PG8_BAR; PG8_SCHED;
            PG8_LDA(At, 0, 1); PG8_STAGE(PG8_SB(0, 0), b2, voffB); PG8_STAGE(PG8_SB(0, 1), b2 + hstepB, voffB); PG8_STAGE(PG8_SA(0, 0), a2, voffA);
            PG8_WAIT_V(8); PG8_WAIT_L(0); PG8_BAR; PG8_MMA(1, 0, At, B0); PG8_MMA(1, 1, At, B1); PG8_BAR; PG8_SCHED;
            PG8_LDB(B0, 1, 0); PG8_LDB(B1, 1, 1); PG8_SCHED; PG8_LDA(At, 1, 0); PG8_STAGE(PG8_SA(0, 1), a2 + hstepA, voffA);
            PG8_WAIT_V(8); PG8_WAIT_L(0); PG8_BAR; PG8_MMA(0, 0, At, B0); PG8_MMA(0, 1, At, B1); PG8_BAR; PG8_SCHED;
            PG8_LDA(At, 1, 1); PG8_STAGE(PG8_SB(1, 0), b3, voffB); PG8_STAGE(PG8_SB(1, 1), b3 + hstepB, voffB); PG8_STAGE(PG8_SA(1, 0), a3, voffA);
            PG8_WAIT_V(8); PG8_WAIT_L(0); PG8_BAR; PG8_MMA(1, 0, At, B0); PG8_MMA(1, 1, At, B1); PG8_BAR; PG8_SCHED;
            } else {
            PG8_LDB(B0, 0, 0); PG8_SCHED; PG8_LDA(At, 0, 0); PG8_STAGE(PG8_SA(1, 1), a1 + hstepA, voffA);
            PG8_WAIT_L(8); PG8_BAR; PG8_WAIT_L(0); PG8_MMA(0, 0, At, B0); PG8_BAR; PG8_SCHED;
            PG8_LDB(B1, 0, 1); PG8_STAGE(PG8_SB(0, 0), b2, voffB);
            PG8_BAR; PG8_WAIT_L(0); PG8_MMA(0, 1, At, B1); PG8_BAR;
            PG8_LDA(At, 0, 1); PG8_STAGE(PG8_SA(0, 0), a2, voffA);
            PG8_BAR; PG8_WAIT_L(0); PG8_MMA(1, 0, At, B0); PG8_BAR; PG8_SCHED;
            PG8_STAGE(PG8_SB(0, 1), b2 + hstepB, voffB);
            PG8_WAIT_V(6); PG8_BAR; PG8_MMA(1, 1, At, B1); PG8_BAR;
            PG8_LDB(B0, 1, 0); PG8_SCHED; PG8_LDA(At, 1, 0); PG8_STAGE(PG8_SA(0, 1), a2 + hstepA, voffA);
            PG8_WAIT_L(8); PG8_BAR; PG8_WAIT_L(0); PG8_MMA(0, 0, At, B0); PG8_BAR; PG8_SCHED;
            PG8_LDB(B1, 1, 1); PG8_STAGE(PG8_SB(1, 0), b3, voffB);
            PG8_BAR; PG8_WAIT_L(0); PG8_MMA(0, 1, At, B1); PG8_BAR;
            PG8_LDA(At, 1, 1); PG8_STAGE(PG8_SA(1, 0), a3, voffA);
            PG8_BAR; PG8_WAIT_L(0); PG8_MMA(1, 0, At, B0); PG8_BAR; PG8_SCHED;
            PG8_STAGE(PG8_SB(1, 1), b3 + hstepB, voffB);
            PG8_WAIT_V(6); PG8_BAR; PG8_MMA(1, 1, At, B1); PG8_BAR;
            }
        }
        if constexpr (ALIGN_EPI) { if (wr == 0) PG8_BAR; }
        if constexpr (!Epi::AFTER_DRAIN) { E(acc, cur, wr, wc, fr, fq); }
        if (!has_next) break;
#pragma unroll
        for (int a = 0; a < 2; ++a)
#pragma unroll
            for (int b = 0; b < 2; ++b)
#pragma unroll
                for (int m = 0; m < 4; ++m)
#pragma unroll
                    for (int n = 0; n < 2; ++n) acc[a][b][m][n] = (f32x4){0.f, 0.f, 0.f, 0.f};
        cur = nxt; cA = nA; cB = nB; ++ui;
        if constexpr (ALIGN_EPI) { if (wr == 1) PG8_BAR; }
    }
    PG8_WAIT_V(0);
    if constexpr (!ALIGN_EPI) { if (wr == 0) PG8_BAR; }
    PG8_BAR;
    if constexpr (Epi::AFTER_DRAIN) { E.fused(acc, cur, wr, wc, fr, fq, lds, wid, lane); }
#undef PG8_SA
#undef PG8_SB
#undef PG8_STAGE
#undef PG8_LDA
#undef PG8_LDB
#undef PG8_MMA
#undef PG8_WAIT_V
#undef PG8_WAIT_L
#undef PG8_BAR
#undef PG8_SCHED
}

struct EpiZ {
    static constexpr bool PERM = true, AFTER_DRAIN = false, HAS_MID = false;
    bf16_t *U, *A2, *Q, *KT, *VT, *RHO, *GA; const float *rstd, *pscale, *ropec, *ropes; int S, pad;
    __device__ __forceinline__ void operator()(const f32x4 (&acc)[2][2][4][2], const Unit& u, int wr, int wc, int fr, int fq) const {
        { int t_ = threadIdx.x; asm volatile("" : "+v"(t_)); fr = t_ & 15; fq = (t_ >> 4) & 3; }
        const int pn = u.pn, rowb = u.pm * BM + wr * 64 + fr, cl = wc * 32 + 8 * fq;
        float rs[2][4];
#pragma unroll
        for (int ai = 0; ai < 2; ++ai)
#pragma unroll
            for (int m = 0; m < 4; ++m) rs[ai][m] = rstd[rowb + ai * HALF + m * 16];
        if (pn < 4 || pn == 13) {
#pragma unroll
            for (int ai = 0; ai < 2; ++ai)
#pragma unroll
                for (int m = 0; m < 4; ++m) { const int r = rowb + ai * HALF + m * 16; const float s = rs[ai][m];
#pragma unroll
                    for (int bj = 0; bj < 2; ++bj) { const f32x4 v0 = acc[ai][bj][m][0] * s, v1 = acc[ai][bj][m][1] * s;
                        u32x4 w; w.x = cvtpk(v0[0], v0[1]); w.y = cvtpk(v0[2], v0[3]); w.z = cvtpk(v1[0], v1[1]); w.w = cvtpk(v1[2], v1[3]);
                        bf16_t* dst;
                        if (pn < 4) dst = U + (size_t)r * DM + pn * BM + bj * HALF + cl;
                        else { const int hk = bj * 2 + (wc >> 1), dh = wc & 1; dst = VT + ((size_t)(((r >> 6) * 4 + hk) * 2 + dh) * 64 + (r & 63)) * 32 + fq * 8; }
                        *(u32x4*)dst = w; } }
        } else if (pn < 8 || (pn >= 14 && pn < 18)) {
            const bool pg = pn < 8; const int cb = pg ? (pn - 4) * BM : (pn - 14) * BM;
            f32x4 ps[2][2];
#pragma unroll
            for (int bj = 0; bj < 2; ++bj)
#pragma unroll
                for (int n = 0; n < 2; ++n) ps[bj][n] = pg ? *(const f32x4*)(pscale + cb + bj * HALF + cl + 4 * n) : (f32x4){1.f, 1.f, 1.f, 1.f};
#pragma unroll
            for (int ai = 0; ai < 2; ++ai)
#pragma unroll
                for (int m = 0; m < 4; ++m) { const int r = rowb + ai * HALF + m * 16; const float s = rs[ai][m];
#pragma unroll
                    for (int bj = 0; bj < 2; ++bj) { f32x4 v0 = acc[ai][bj][m][0] * s, v1 = acc[ai][bj][m][1] * s;
#pragma unroll
                        for (int e = 0; e < 4; ++e) { v0[e] = silu_f(v0[e]) * ps[bj][0][e]; v1[e] = silu_f(v1[e]) * ps[bj][1][e]; }
                        u32x4 w; w.x = cvtpk(v0[0], v0[1]); w.y = cvtpk(v0[2], v0[3]); w.z = cvtpk(v1[0], v1[1]); w.w = cvtpk(v1[2], v1[3]);
                        *(u32x4*)(A2 + (size_t)r * 2048 + (pg ? 0 : 1024) + cb + bj * HALF + cl) = w; } }
        } else if (pn < 13) {
            const bool isq = pn < 12; const int i0 = 16 * (wc & 1) + 4 * fq; const float sc = isq ? QSCALE : 1.f;
#pragma unroll
            for (int ai = 0; ai < 2; ++ai)
#pragma unroll
                for (int m = 0; m < 4; ++m) { const int r = rowb + ai * HALF + m * 16; const float s = rs[ai][m] * sc; const int pos = r & (S - 1);
                    const f32x4 cs = *(const f32x4*)(ropec + pos * 32 + i0), sn = *(const f32x4*)(ropes + pos * 32 + i0);
#pragma unroll
                    for (int bj = 0; bj < 2; ++bj) { const f32x4 x1 = acc[ai][bj][m][0] * s, x2 = acc[ai][bj][m][1] * s;
                        const f32x4 o1 = x1 * cs - x2 * sn, o2 = x2 * cs + x1 * sn;
                        u32x4 w; w.x = cvtpk(o1[0], o1[1]); w.y = cvtpk(o1[2], o1[3]); w.z = cvtpk(o2[0], o2[1]); w.w = cvtpk(o2[2], o2[3]);
                        bf16_t* dst;
                        if (isq) dst = Q + (size_t)r * DM + (pn - 8) * BM + bj * HALF + cl;
                        else { const int hk = bj * 2 + (wc >> 1), ch = 4 * (wc & 1) + fq; dst = KT + ((size_t)(((r >> 6) * 4 + hk) * 8 + ch) * 64 + (r & 63)) * 8; }
                        *(u32x4*)dst = w; } }
        } else {
            const int cb = (pn - 18) * HALF;
#pragma unroll
            for (int ai = 0; ai < 2; ++ai)
#pragma unroll
                for (int m = 0; m < 4; ++m) { const int r = rowb + ai * HALF + m * 16; const float s = rs[ai][m];
#pragma unroll
                    for (int bj = 0; bj < 2; ++bj) { const f32x4 a = acc[ai][bj][m][0] * s, b = acc[ai][bj][m][1] * s; float ga[4], rho[4];
#pragma unroll
                        for (int e = 0; e < 4; ++e) { const float ea = fexp(-fminf(fmaxf(a[e], -30.f), 30.f)), eb = fexp(-fminf(fmaxf(b[e], -30.f), 30.f));
                            ga[e] = __builtin_amdgcn_rcpf(1.f + eb); rho[e] = (1.f + eb) * __builtin_amdgcn_rcpf(1.f + ea); }
                        const size_t off = (size_t)r * DM + cb + bj * 64 + wc * 16 + fq * 4;
                        u32x2 wr_, wg_; wr_.x = cvtpk(rho[0], rho[1]); wr_.y = cvtpk(rho[2], rho[3]); wg_.x = cvtpk(ga[0], ga[1]); wg_.y = cvtpk(ga[2], ga[3]);
                        *(u32x2*)(RHO + off) = wr_; *(u32x2*)(GA + off) = wg_; } }
        }
    }
};
struct EpiPB {
    static constexpr bool PERM = true, AFTER_DRAIN = false, HAS_MID = false;
    bf16_t* A2;
    __device__ __forceinline__ void operator()(const f32x4 (&acc)[2][2][4][2], const Unit& u, int wr, int wc, int fr, int fq) const {
        { int t_ = threadIdx.x; asm volatile("" : "+v"(t_)); fr = t_ & 15; fq = (t_ >> 4) & 3; }
        const int rowb = u.pm * BM + wr * 64 + fr, col0 = u.pn * BM + wc * 32 + 8 * fq;
#pragma unroll
        for (int ai = 0; ai < 2; ++ai)
#pragma unroll
            for (int m = 0; m < 4; ++m) { bf16_t* rowp = A2 + (size_t)(rowb + ai * HALF + m * 16) * 2048 + col0;
#pragma unroll
                for (int bj = 0; bj < 2; ++bj) { const u32x4 g = *(const u32x4*)(rowp + bj * HALF); const f32x4 v0 = acc[ai][bj][m][0], v1 = acc[ai][bj][m][1];
                    u32x4 w; w.x = cvtpk(v0[0] * bf_lo(g.x), v0[1] * bf_hi(g.x)); w.y = cvtpk(v0[2] * bf_lo(g.y), v0[3] * bf_hi(g.y));
                    w.z = cvtpk(v1[0] * bf_lo(g.z), v1[1] * bf_hi(g.z)); w.w = cvtpk(v1[2] * bf_lo(g.w), v1[3] * bf_hi(g.w));
                    *(u32x4*)(rowp + bj * HALF) = w; }
                if (m & 1) asm volatile("" ::: "memory"); }
    }
};
struct EpiM {
    static constexpr bool PERM = true, AFTER_DRAIN = false, HAS_MID = true;
    const bf16_t *RHO, *GA; bf16_t* Mo;
    __device__ __forceinline__ void mid(f32x4 (&acc)[2][2][4][2], const Unit& u, int wr, int wc, int fr, int fq) const {
        { int t_ = threadIdx.x; asm volatile("" : "+v"(t_)); fr = t_ & 15; fq = (t_ >> 4) & 3; }
        const int rowb = u.pm * BM + wr * 64 + fr, col0 = u.pn * BM + wc * 32 + 8 * fq;
#pragma unroll
        for (int ai = 0; ai < 2; ++ai)
#pragma unroll
            for (int m = 0; m < 4; ++m) { const bf16_t* rowp = RHO + (size_t)(rowb + ai * HALF + m * 16) * DM + col0;
#pragma unroll
                for (int bj = 0; bj < 2; ++bj) { const u32x4 g = *(const u32x4*)(rowp + bj * HALF);
                    acc[ai][bj][m][0] *= (f32x4){bf_lo(g.x), bf_hi(g.x), bf_lo(g.y), bf_hi(g.y)}; acc[ai][bj][m][1] *= (f32x4){bf_lo(g.z), bf_hi(g.z), bf_lo(g.w), bf_hi(g.w)}; }
                if (m & 1) asm volatile("" ::: "memory"); }
    }
    __device__ __forceinline__ void operator()(const f32x4 (&acc)[2][2][4][2], const Unit& u, int wr, int wc, int fr, int fq) const {
        { int t_ = threadIdx.x; asm volatile("" : "+v"(t_)); fr = t_ & 15; fq = (t_ >> 4) & 3; }
        const int rowb = u.pm * BM + wr * 64 + fr, col0 = u.pn * BM + wc * 32 + 8 * fq;
#pragma unroll
        for (int ai = 0; ai < 2; ++ai)
#pragma unroll
            for (int m = 0; m < 4; ++m) { const size_t ro = (size_t)(rowb + ai * HALF + m * 16) * DM + col0;
#pragma unroll
                for (int bj = 0; bj < 2; ++bj) { const u32x4 g = *(const u32x4*)(GA + ro + bj * HALF); const f32x4 v0 = acc[ai][bj][m][0], v1 = acc[ai][bj][m][1];
                    u32x4 w; w.x = cvtpk(v0[0] * bf_lo(g.x), v0[1] * bf_hi(g.x)); w.y = cvtpk(v0[2] * bf_lo(g.y), v0[3] * bf_hi(g.y));
                    w.z = cvtpk(v1[0] * bf_lo(g.z), v1[1] * bf_hi(g.z)); w.w = cvtpk(v1[2] * bf_lo(g.w), v1[3] * bf_hi(g.w));
                    *(u32x4*)(Mo + ro + bj * HALF) = w; }
                if (m & 1) asm volatile("" ::: "memory"); }
    }
};
struct EpiF32 {
    static constexpr bool PERM = false, AFTER_DRAIN = false, HAS_MID = false;
    float* C; int ldc, pad;
    __device__ __forceinline__ void operator()(const f32x4 (&acc)[2][2][4][2], const Unit& u, int wr, int wc, int fr, int fq) const {
        { int t_ = threadIdx.x; asm volatile("" : "+v"(t_)); fr = t_ & 15; fq = (t_ >> 4) & 3; }
        const int row0 = u.pm * BM + wr * 64 + fr, col0 = u.pn * BM + wc * 32 + 4 * fq;
#pragma unroll
        for (int ai = 0; ai < 2; ++ai)
#pragma unroll
            for (int m = 0; m < 4; ++m) { float* rowp = C + (size_t)(row0 + ai * HALF + m * 16) * ldc + col0;
#pragma unroll
                for (int bj = 0; bj < 2; ++bj)
#pragma unroll
                    for (int n = 0; n < 2; ++n) *(f32x4*)(rowp + bj * HALF + n * 16) = acc[ai][bj][m][n]; }
    }
};
}

namespace att {
constexpr int SLOT = 8192, LDS_K = 0, LDS_V = 5 * SLOT, LDS_WS = 10 * SLOT, LDS_OST = LDS_WS + 8 * 256, LDS_END = LDS_OST + 8 * 4096;
__device__ __forceinline__ int crow(int r, int hi) { return (r & 3) + 8 * (r >> 2) + 4 * hi; }
__device__ __forceinline__ s16x4 vtr(const LAS unsigned char* p) { typedef short v4i16_t __attribute__((ext_vector_type(4))); return __builtin_bit_cast(s16x4, __builtin_amdgcn_ds_read_tr16_b64_v4i16((LAS v4i16_t*)p)); }

template <int THRL>
__device__ __forceinline__ void attn_unit(LAS unsigned char* shm, int row0  , int S, int hk, int qb,
                                          const bf16_t* Q, const bf16_t* KT, const bf16_t* VT, bf16_t* A2, const float* sink) {
    int tid_ = threadIdx.x; asm volatile("" : "+v"(tid_));
    const int tid = tid_, lane = tid & 63, r32 = lane & 31, hi = lane >> 5, wid = __builtin_amdgcn_readfirstlane(tid >> 6);
    const int hq = hk * 4 + (wid & 3), qh = 2 * qb + (wid >> 2), ntile = S >> 6, T0 = row0 >> 6;
#pragma unroll
    for (int s = 0; s < 5; ++s) { const int tile = qb - 2 + s;
        if (tile >= 0 && tile < ntile) {
            const u32x4 kv = *(const u32x4*)((const char*)KT + ((size_t)((T0 + tile) * 4 + hk) << 13) + tid * 16);
            const u32x4 vv = *(const u32x4*)((const char*)VT + ((size_t)((T0 + tile) * 4 + hk) << 13) + tid * 16);
            *(LAS u32x4*)(shm + LDS_K + s * SLOT + tid * 16) = kv; *(LAS u32x4*)(shm + LDS_V + s * SLOT + tid * 16) = vv; } }
    const size_t qrow = (size_t)(row0 + qh * 32 + r32);
    bf16x8 qr[4];
#pragma unroll
    for (int s = 0; s < 4; ++s) qr[s] = *(const bf16x8*)(Q + qrow * DM + hq * 64 + s * 16 + hi * 8);
    LAS float* wsf = (LAS float*)(shm + LDS_WS) + wid * 64;
    float mhat = sink[hq] * LOG2E, l_reg = (hi == 0) ? 1.f : 0.f;
    f32x16 o[2]; o[0] = f32x16{}; o[1] = f32x16{};
    __syncthreads();
    const LAS unsigned char* vb0 = shm + LDS_V + ((lane >> 4) & 1) * 32 + (lane & 3) * 8 + (4 * hi + ((lane & 15) >> 2)) * 64;
    for (int i = 0; i < 9; ++i) {
        const int ht = qh - 4 + i;
        if (ht < 0 || ht >= 2 * ntile) continue;
        const int slot = (ht >> 1) - (qb - 2), half = ht & 1;
        const LAS unsigned char* kp = shm + LDS_K + slot * SLOT + half * 512 + hi * 1024 + r32 * 16;
        f32x16 p;
#pragma unroll
        for (int r = 0; r < 16; ++r) p[r] = -mhat;
#pragma unroll
        for (int s = 0; s < 4; ++s) { const bf16x8 kf = *(const LAS bf16x8*)(kp + s * 2048); p = __builtin_amdgcn_mfma_f32_32x32x16_bf16(kf, qr[s], p, 0, 0, 0); }
        if (i == 0) {
#pragma unroll
            for (int r = 0; r < 16; ++r) if (crow(r, hi) < r32) p[r] = -INFINITY;
        }
        if (i == 8) {
#pragma unroll
            for (int r = 0; r < 16; ++r) if (crow(r, hi) > r32) p[r] = -INFINITY;
        }
        float rm = fmaxf(fmaxf(p[0], p[1]), fmaxf(p[2], p[3]));
#pragma unroll
        for (int r = 4; r < 16; r += 4) rm = fmaxf(rm, fmaxf(fmaxf(p[r], p[r + 1]), fmaxf(p[r + 2], p[r + 3])));
        { auto rr = __builtin_amdgcn_permlane32_swap(__float_as_uint(rm), __float_as_uint(rm), false, false); rm = fmaxf(__uint_as_float(rr[0]), __uint_as_float(rr[1])); }
        if (__any(rm > (float)THRL)) {
            const float dl = fmaxf(rm, 0.f); mhat += dl;
#pragma unroll
            for (int r = 0; r < 16; ++r) p[r] -= dl;
            const float f = __builtin_amdgcn_exp2f(-dl); l_reg *= f;
            if (hi == 0) wsf[r32] = f;
            asm volatile("s_waitcnt lgkmcnt(0)" ::: "memory");
#pragma unroll
            for (int r = 0; r < 16; ++r) { const float fr_ = wsf[crow(r, hi)]; o[0][r] *= fr_; o[1][r] *= fr_; }
            asm volatile("s_waitcnt lgkmcnt(0)" ::: "memory");
        }
        float sacc = 0.f;
#pragma unroll
        for (int r = 0; r < 16; ++r) { p[r] = __builtin_amdgcn_exp2f(p[r]); sacc += p[r]; }
        l_reg += sacc;
        u32x4 pw0, pw1;
        pw0.x = cvtpk(p[0], p[1]); pw0.y = cvtpk(p[2], p[3]); pw0.z = cvtpk(p[4], p[5]); pw0.w = cvtpk(p[6], p[7]);
        pw1.x = cvtpk(p[8], p[9]); pw1.y = cvtpk(p[10], p[11]); pw1.z = cvtpk(p[12], p[13]); pw1.w = cvtpk(p[14], p[15]);
        const bf16x8 pa0 = __builtin_bit_cast(bf16x8, pw0), pa1 = __builtin_bit_cast(bf16x8, pw1);
        const LAS unsigned char* vb = vb0 + slot * SLOT + half * 2048;
#pragma unroll
        for (int dh = 0; dh < 2; ++dh) {
            const s16x4 l0 = vtr(vb + dh * 4096), h0 = vtr(vb + dh * 4096 + 512), l1 = vtr(vb + dh * 4096 + 1024), h1 = vtr(vb + dh * 4096 + 1536);
            const bf16x8 v0 = (bf16x8){l0[0], l0[1], l0[2], l0[3], h0[0], h0[1], h0[2], h0[3]}, v1 = (bf16x8){l1[0], l1[1], l1[2], l1[3], h1[0], h1[1], h1[2], h1[3]};
            o[dh] = __builtin_amdgcn_mfma_f32_32x32x16_bf16(pa0, v0, o[dh], 0, 0, 0);
            o[dh] = __builtin_amdgcn_mfma_f32_32x32x16_bf16(pa1, v1, o[dh], 0, 0, 0);
        }
    }
    { auto rr = __builtin_amdgcn_permlane32_swap(__float_as_uint(l_reg), __float_as_uint(l_reg), false, false); l_reg = __uint_as_float(rr[0]) + __uint_as_float(rr[1]); }
    if (hi == 0) wsf[32 + r32] = l_reg;
    asm volatile("s_waitcnt lgkmcnt(0)" ::: "memory");
    LAS bf16_t* stg = (LAS bf16_t*)(shm + LDS_OST) + wid * 2048;
#pragma unroll
    for (int r = 0; r < 16; ++r) { const int orow = crow(r, hi); const float rl = __builtin_amdgcn_rcpf(wsf[32 + orow]);
        stg[orow * 64 + r32] = (bf16_t)(cvtpk(o[0][r] * rl, 0.f) & 0xffffu); stg[orow * 64 + 32 + r32] = (bf16_t)(cvtpk(o[1][r] * rl, 0.f) & 0xffffu); }
    asm volatile("s_waitcnt lgkmcnt(0)" ::: "memory");
    bf16_t* orow0 = A2 + (size_t)(row0 + qh * 32) * 2048 + 1024 + hq * 64;
#pragma unroll
    for (int i = 0; i < 4; ++i) { const int row = i * 8 + (lane >> 3), ch = lane & 7; const u32x4 v = *(const LAS u32x4*)(stg + row * 64 + ch * 8);
        bf16_t* gp = orow0 + (size_t)row * 2048 + ch * 8; const u32x4 g = *(const u32x4*)gp;
        u32x4 w; w.x = cvtpk(bf_lo(v.x) * bf_lo(g.x), bf_hi(v.x) * bf_hi(g.x)); w.y = cvtpk(bf_lo(v.y) * bf_lo(g.y), bf_hi(v.y) * bf_hi(g.y));
        w.z = cvtpk(bf_lo(v.z) * bf_lo(g.z), bf_hi(v.z) * bf_hi(g.z)); w.w = cvtpk(bf_lo(v.w) * bf_lo(g.w), bf_hi(v.w) * bf_hi(g.w));
        *(u32x4*)gp = w; }
    __syncthreads();
}
}

constexpr int NWAVES = 8;
#ifndef MK_MULTI
#define MK_MULTI 0
#endif
constexpr size_t MiB = 1u << 20;
constexpr size_t WS_CTL = 0, CTL_ZERO_BYTES = 1 * MiB;
constexpr size_t WS_WIN = 1 * MiB, WS_WPG = 14 * MiB, WS_W2 = 15 * MiB, WS_WOUT = 19 * MiB, WS_ROPE = 21 * MiB, WS_RSTD = 23 * MiB;
constexpr size_t WS_A2 = 32 * MiB, WS_U = 160 * MiB, WS_Q = 224 * MiB, WS_KT = 288 * MiB, WS_VT = 304 * MiB, WS_RHO = 320 * MiB, WS_GA = 384 * MiB, WS_END = 448 * MiB;
constexpr size_t WS_M = WS_U;
constexpr int CW_BAR = 4096;
constexpr int RING_BYTES = 131072, LDSCTL_OFF = RING_BYTES, MISC_OFF = LDSCTL_OFF + 320, LDS_BYTES = 147456;
static_assert(att::LDS_END <= RING_BYTES, "attention scratch fits the ring");

typedef GAS unsigned gu32;
#define XB_TMO      128
#define XB_XCNT(j)  (256  + 64 * (j))
#define XB_XSUB(j)  (1280 + 64 * (j))
#define XB_XGEN(j)  (2304 + 64 * (j))
#define XB_TOP      3328
#define XB_TOPGEN   3392
#define XCD_BAR_WORDS 3456
#define XB_SPIN_CAP (1u << 18)
__device__ __forceinline__ unsigned xb_ld(unsigned* p)              { return __hip_atomic_load(p, __ATOMIC_RELAXED, __HIP_MEMORY_SCOPE_AGENT); }
__device__ __forceinline__ unsigned xb_add(unsigned* p, unsigned v) { return __hip_atomic_fetch_add(p, v, __ATOMIC_RELAXED, __HIP_MEMORY_SCOPE_AGENT); }
__device__ __forceinline__ unsigned xb_xcc_id() { return (unsigned)__builtin_amdgcn_s_getreg((3 << 11) | 20) & 0xFu; }
#define XB_SPIN(cond, bar) do { unsigned _sp = 0; while (cond) { __builtin_amdgcn_s_sleep(1); \
    if ((++_sp & 255u) == 0u) { if (xb_ld(&(bar)[XB_TMO])) break; if (_sp > XB_SPIN_CAP) { atomicAdd(&(bar)[XB_TMO], 1u); break; } } } } while (0)
struct XcdBarrier { unsigned* bar; unsigned x; volatile LAS unsigned* st; };
__device__ __forceinline__ XcdBarrier xcd_barrier_post(unsigned* bar, volatile LAS unsigned* st) {
    XcdBarrier b; b.bar = bar; b.x = xb_xcc_id(); b.st = st;
    if (threadIdx.x == 0) (void)xb_add(&bar[XB_XCNT(b.x)], 1u);
    return b;
}
__device__ __forceinline__ void xcd_barrier_complete(unsigned* bar, unsigned x, unsigned& nloc, unsigned& nx) {
    const unsigned G = gridDim.x * gridDim.y * gridDim.z;
    unsigned sum, cnt, mine, sp = 0u;
    for (;;) {
        sum = 0u; cnt = 0u; mine = 0u;
#pragma unroll
        for (unsigned j = 0; j < 16; ++j) { const unsigned c = xb_ld(&bar[XB_XCNT(j)]); sum += c; cnt += (c > 0u) ? 1u : 0u; mine = (j == x) ? c : mine; }
        if (sum == G) break;
        __builtin_amdgcn_s_sleep(1);
        if ((++sp & 255u) == 0u) { if (xb_ld(&bar[XB_TMO])) break; if (sp > XB_SPIN_CAP) { atomicAdd(&bar[XB_TMO], 1u); break; } }
    }
    nloc = mine > 0u ? mine : 1u; nx = cnt > 0u ? cnt : 1u;
}
__device__ __forceinline__ void xcd_barrier(const XcdBarrier& b) {
    asm volatile("s_waitcnt vmcnt(0)" ::: "memory");
    __syncthreads();
    if (threadIdx.x == 0) {
        unsigned* bar = b.bar;
        __builtin_amdgcn_s_waitcnt(0);
        unsigned nloc = b.st[0], nx = b.st[1];
        if (nloc == 0u) { xcd_barrier_complete(bar, b.x, nloc, nx); b.st[0] = nloc; b.st[1] = nx; }
        const unsigned old = xb_add(&bar[XB_XSUB(b.x)], 1u);
        const unsigned gen = old / nloc;
        if (old + 1u == (gen + 1u) * nloc) {
            __builtin_amdgcn_fence(__ATOMIC_RELEASE, "agent");
            asm volatile("s_waitcnt vmcnt(0)" ::: "memory");
            const unsigned og = xb_add(&bar[XB_TOP], 1u);
            const unsigned tg = og / nx;
            if (og + 1u == (tg + 1u) * nx) xb_add(&bar[XB_TOPGEN], 1u);
            else XB_SPIN(xb_ld(&bar[XB_TOPGEN]) == tg, bar);
            __builtin_amdgcn_fence(__ATOMIC_ACQUIRE, "agent");
            xb_add(&bar[XB_XGEN(b.x)], 1u);
            asm volatile("s_waitcnt vmcnt(0)" ::: "memory");
        } else {
            XB_SPIN(xb_ld(&bar[XB_XGEN(b.x)]) == gen, bar);
            __builtin_amdgcn_fence(__ATOMIC_ACQUIRE, "agent");
            asm volatile("s_waitcnt vmcnt(0)" ::: "memory");
        }
    }
    __syncthreads();
}

__device__ __forceinline__ float wave_sum(float v) {
#define WS_SWZ(o) v += __uint_as_float((unsigned)__builtin_amdgcn_ds_swizzle((int)__float_as_uint(v), 0x1f | ((o) << 10)))
    WS_SWZ(1); WS_SWZ(2); WS_SWZ(4); WS_SWZ(8); WS_SWZ(16);
#undef WS_SWZ
    auto rr = __builtin_amdgcn_permlane32_swap(__float_as_uint(v), __float_as_uint(v), false, false);
    return __uint_as_float(rr[0]) + __uint_as_float(rr[1]);
}
__device__ __forceinline__ int win_src_col(int n) {
    if (n < 2048) return n;
    if (n < 3328) { const int j = n & 63, base = n - j, i8 = j >> 3, w = j & 7; return base + ((w < 4) ? (4 * i8 + w) : (32 + 4 * i8 + (w - 4))); }
    if (n < 4608) return n;
    const int j = n - 4608, blk = j >> 3, w = j & 7; return 4608 + ((w < 4) ? (4 * blk + w) : (1024 + 4 * blk + (w - 4)));
}
template <bool WIN>
__device__ __forceinline__ void p0_transpose_item(const float* W, int N, const float* gk, bf16_t* WT, int ldt, int row_off, int col_off, LAS float* scr, int item, int lane) {
    const int nblk = N / 32, kb = item / nblk, nb = item % nblk, k0 = 64 * kb, n0 = 32 * nb;
    const int sc = WIN ? win_src_col(n0 + (lane & 31)) : (n0 + (lane & 31));
#pragma unroll 8
    for (int i = 0; i < 32; ++i) { const int kk = 2 * i + (lane >> 5); float v = W[(size_t)(k0 + kk) * N + sc]; if (WIN) v *= gk[k0 + kk]; scr[kk * 33 + (lane & 31)] = v; }
    asm volatile("s_waitcnt lgkmcnt(0)" ::: "memory");
    const int c = lane & 7;
#pragma unroll
    for (int j = 0; j < 4; ++j) { const int n = (lane >> 3) + 8 * j; const LAS float* s = scr + (8 * c) * 33 + n;
        u32x4 o; o.x = cvtpk(s[0 * 33], s[1 * 33]); o.y = cvtpk(s[2 * 33], s[3 * 33]); o.z = cvtpk(s[4 * 33], s[5 * 33]); o.w = cvtpk(s[6 * 33], s[7 * 33]);
        *(u32x4*)(WT + (size_t)(row_off + n0 + n) * ldt + col_off + k0 + 8 * c) = o; }
    asm volatile("s_waitcnt lgkmcnt(0)" ::: "memory");
}

struct Args { const float* in[11]; float* out; unsigned char* ws; int st_lo, st_hi; };

__global__ void __launch_bounds__(NWAVES * 64, 2) mk_fwd(Args args) {
    extern __shared__ __attribute__((aligned(16))) unsigned char lds_raw[];
    LAS unsigned char* lds = (LAS unsigned char*)lds_raw;
    volatile LAS unsigned* MISC = (volatile LAS unsigned*)(lds + MISC_OFF);
    const int tid = threadIdx.x, lane = tid & 63, wave = __builtin_amdgcn_readfirstlane(tid >> 6);
    const int G = gridDim.x, bx = blockIdx.x;
    const int vcu = (G % 8 == 0) ? (bx % 8) * (G / 8) + bx / 8 : bx;
    unsigned char* ws = args.ws;
    const float* x_prompt = args.in[0]; const float* x_sample = args.in[1]; const float* norm_pre = args.in[2]; const float* w_in = args.in[3]; const float* w_pg = args.in[4];
    const float* pool_scale = args.in[5]; const float* w_pp = args.in[6]; const float* sink = args.in[7]; const float* w_ap = args.in[8]; const float* w_out = args.in[9]; const float* norm_post = args.in[10];
    bf16_t* WIN_T = (bf16_t*)(ws + WS_WIN); bf16_t* WPG_T = (bf16_t*)(ws + WS_WPG); bf16_t* W2_T = (bf16_t*)(ws + WS_W2); bf16_t* WOUT_T = (bf16_t*)(ws + WS_WOUT);
    float* ROPEC = (float*)(ws + WS_ROPE); float* ROPES = ROPEC + 8192 * 32; float* RSTD = (float*)(ws + WS_RSTD);
    bf16_t* A2 = (bf16_t*)(ws + WS_A2); bf16_t* U = (bf16_t*)(ws + WS_U); bf16_t* Qb = (bf16_t*)(ws + WS_Q); bf16_t* KT = (bf16_t*)(ws + WS_KT); bf16_t* VT = (bf16_t*)(ws + WS_VT);
    bf16_t* RHO = (bf16_t*)(ws + WS_RHO); bf16_t* GA = (bf16_t*)(ws + WS_GA); bf16_t* Mb = (bf16_t*)(ws + WS_M);

    for (int u = tid; u < (LDS_BYTES - LDSCTL_OFF) / 4; u += NWAVES * 64) ((LAS unsigned*)(lds + LDSCTL_OFF))[u] = 0u;
    __syncthreads();
    XcdBarrier bar; bar.bar = (unsigned*)(ws + WS_CTL) + CW_BAR; bar.x = 0; bar.st = nullptr;
    if (!MK_MULTI) bar = xcd_barrier_post((unsigned*)(ws + WS_CTL) + CW_BAR, MISC + 8);

    const int gw = vcu * NWAVES + wave, NGW = G * NWAVES;
    const int lo = args.st_lo, hi_ = args.st_hi;
#define IN(k) (lo <= (k) && (k) < hi_)
#define SEAM(k) do { if (IN(k) && IN((k) + 1)) xcd_barrier(bar); } while (0)
    {
        if (IN(0)) {
            LAS float* scr = (LAS float*)(lds + wave * 16384);
            constexpr int I_WIN = (DM / 64) * (INW / 32), I_PG = (256 / 64) * (256 / 32), I_SQ = (DM / 64) * (DM / 32);
            constexpr int NITEMS = I_WIN + 4 * I_PG + 3 * I_SQ;
            for (int it = gw; it < NITEMS; it += NGW) {
                int r = it;
                if (r < I_WIN) { p0_transpose_item<true>(w_in, INW, norm_pre, WIN_T, DM, 0, 0, scr, r, lane); continue; } r -= I_WIN;
                if (r < 4 * I_PG) { const int g = r / I_PG; p0_transpose_item<false>(w_pg + (size_t)g * 65536, 256, nullptr, WPG_T, 256, g * 256, 0, scr, r % I_PG, lane); continue; } r -= 4 * I_PG;
                if (r < I_SQ) { p0_transpose_item<false>(w_pp, DM, nullptr, W2_T, 2048, 0, 0, scr, r, lane); continue; } r -= I_SQ;
                if (r < I_SQ) { p0_transpose_item<false>(w_ap, DM, nullptr, W2_T, 2048, 0, 1024, scr, r, lane); continue; } r -= I_SQ;
                p0_transpose_item<false>(w_out, DM, nullptr, WOUT_T, DM, 0, 0, scr, r, lane);
            }
            for (int m = gw; m < NTOK; m += NGW) {
                const float* xrow = (m < CHT ? x_prompt + (size_t)m * DM : x_sample + (size_t)(m - CHT) * DM);
                bf16_t* orow = (bf16_t*)(args.out + (size_t)(m / CHT) * CHT * DM) + (size_t)(m % CHT) * DM;
                const f32x4* xr = (const f32x4*)xrow + lane;
                f32x4 v[4]; float s = 0.f;
#pragma unroll
                for (int j = 0; j < 4; ++j) { v[j] = xr[64 * j]; s += (v[j].x * v[j].x + v[j].y * v[j].y) + (v[j].z * v[j].z + v[j].w * v[j].w); }
                s = wave_sum(s);
                if (lane == 0) RSTD[m] = 1.0f / sqrtf(s * (1.f / DM) + RMS_EPS);
                u32x2* o8 = (u32x2*)orow + lane;
#pragma unroll
                for (int j = 0; j < 4; ++j) { u32x2 w; w.x = cvtpk(v[j].x, v[j].y); w.y = cvtpk(v[j].z, v[j].w); o8[64 * j] = w; }
            }
            for (int e = gw * 64 + lane; e < 8192 * 32; e += NGW * 64) {
                const int i = e & 31, pos = e >> 5;
                const float inv = (float)pow(10000.0, -(double)i / 32.0);
                const float ang = (float)pos * inv;
                ROPEC[e] = (float)cos((double)ang); ROPES[e] = (float)sin((double)ang);
            }
        }
        SEAM(0);
    }
#pragma unroll 1
    for (int c = 0; c < NCHUNK; ++c) {
        const int sb_ = 1 + 6 * c;
        const int S = c == 0 ? 2048 : 8192;
        const float* xc = c == 0 ? x_prompt : x_sample;
        float* yc = args.out + (size_t)c * CHT * DM;
        bf16_t* XB = (bf16_t*)yc;
        bf16_t* POOLED = (bf16_t*)yc + (size_t)CHT * DM;
        const float* rstd_c = RSTD + (size_t)c * CHT;
        if (IN(sb_ + 0)) {
            pg8::Gemm g{XB, WIN_T, DM, DM, DM, 0}; pg8::StaticOrder So; So.init(CHT, INW, G, bx);
            pg8::EpiZ E{U, A2, Qb, KT, VT, RHO, GA, rstd_c, pool_scale, ROPEC, ROPES, S, 0};
            pg8::gemm_phase<pg8::EpiZ, pg8::StaticOrder, true, true>(lds, g, So, E);
        }
        SEAM(sb_ + 0);
        if (IN(sb_ + 1)) {
            int ln = lane; asm volatile("" : "+v"(ln));
            for (int it = gw; it < (CHT / 2) * 4; it += NGW) {
                const int g = it & 3, tok = 2 * (it >> 2) + (ln >> 5), cc = g * 256 + (ln & 31) * 8;
                const int pos = tok & (S - 1), sb = tok - pos, w = 2 << g;
                int wl = pos - (w >> 1), wh = wl + w; wl = wl < 0 ? 0 : wl; wh = wh > S ? S : wh;
                float sm[8];
#pragma unroll
                for (int e = 0; e < 8; ++e) sm[e] = 0.f;
                for (int j = wl; j < wh; ++j) { const u32x4 v = *(const u32x4*)(U + (size_t)(sb + j) * DM + cc);
                    sm[0] += bf_lo(v.x); sm[1] += bf_hi(v.x); sm[2] += bf_lo(v.y); sm[3] += bf_hi(v.y); sm[4] += bf_lo(v.z); sm[5] += bf_hi(v.z); sm[6] += bf_lo(v.w); sm[7] += bf_hi(v.w); }
                const float ic = 1.f / (float)(wh - wl);
                const u32x4 sv = *(const u32x4*)(U + (size_t)tok * DM + cc);
                u32x4 o; o.x = cvtpk(sm[0] * ic - bf_lo(sv.x), sm[1] * ic - bf_hi(sv.x)); o.y = cvtpk(sm[2] * ic - bf_lo(sv.y), sm[3] * ic - bf_hi(sv.y));
                o.z = cvtpk(sm[4] * ic - bf_lo(sv.z), sm[5] * ic - bf_hi(sv.z)); o.w = cvtpk(sm[6] * ic - bf_lo(sv.w), sm[7] * ic - bf_hi(sv.w));
                *(u32x4*)(POOLED + (size_t)tok * DM + cc) = o;
            }
            const int nqb = S >> 6, nunits = (CHT / S) * 4 * nqb, per = (nunits + G - 1) / G;
            for (int k = 0; k < per; ++k) { const int ui = vcu * per + k; if (ui >= nunits) break;
                const int qb = ui % nqb, hk = (ui / nqb) & 3, sq = ui / (nqb * 4);
                att::attn_unit<4>(lds, sq * S, S, hk, qb, Qb, KT, VT, A2, sink); }
        }
        SEAM(sb_ + 1);
        if (IN(sb_ + 2)) {
            pg8::Gemm g{POOLED, WPG_T, DM, 256, 256, 256}; pg8::StaticOrder So; So.init(CHT, DM, G, bx);
            pg8::EpiPB E{A2};
            pg8::gemm_phase<pg8::EpiPB, pg8::StaticOrder, true, true>(lds, g, So, E);
        }
        SEAM(sb_ + 2);
        if (IN(sb_ + 3)) {
            pg8::Gemm g{A2, W2_T, 2048, 2048, 2048, 0}; pg8::StaticOrder So; So.init(CHT, DM, G, bx);
            pg8::EpiM E{RHO, GA, Mb};
            pg8::gemm_phase<pg8::EpiM, pg8::StaticOrder, true, true>(lds, g, So, E);
        }
        SEAM(sb_ + 3);
        if (IN(sb_ + 4)) {
            pg8::Gemm g{Mb, WOUT_T, DM, DM, DM, 0}; pg8::StaticOrder So; So.init(CHT, DM, G, bx);
            pg8::EpiF32 E{yc, DM, 0};
            pg8::gemm_phase<pg8::EpiF32, pg8::StaticOrder, true, true>(lds, g, So, E);
        }
        SEAM(sb_ + 4);
        if (IN(sb_ + 5)) {
            int ln = lane; asm volatile("" : "+v"(ln));
            for (int m = gw; m < CHT; m += NGW) {
                f32x4* orow = (f32x4*)(yc + (size_t)m * DM) + ln; const f32x4* xr = (const f32x4*)(xc + (size_t)m * DM) + ln;
                f32x4 v[4]; float s = 0.f;
#pragma unroll
                for (int j = 0; j < 4; ++j) { v[j] = orow[64 * j]; s += (v[j].x * v[j].x + v[j].y * v[j].y) + (v[j].z * v[j].z + v[j].w * v[j].w); }
                const float r = 1.0f / sqrtf(wave_sum(s) * (1.f / DM) + RMS_EPS);
#pragma unroll
                for (int j = 0; j < 4; ++j) { const f32x4 gg = ((const f32x4*)norm_post)[ln + 64 * j]; orow[64 * j] = xr[64 * j] + v[j] * r * gg; }
            }
        }
        SEAM(sb_ + 5);
    }
#undef IN
#undef SEAM
}

extern "C" void kernel_launch(void* const* d_in, const int* in_sizes, int n_in, void* d_out, int out_size, void* d_ws, size_t ws_size, hipStream_t stream) {
    static int grid = 0;
    if (grid == 0) {
        if (n_in != 11 || out_size != NTOK * DM || ws_size < WS_END) { fprintf(stderr, "kernel_launch: unexpected shapes / workspace (%d inputs, out %d, ws %zu)\n", n_in, out_size, ws_size); grid = -1; return; }
        int dev = 0, cus = 0, per_cu = 0;
        if (hipGetDevice(&dev) != hipSuccess || hipDeviceGetAttribute(&cus, hipDeviceAttributeMultiprocessorCount, dev) != hipSuccess) { grid = -1; return; }
        if (hipFuncSetAttribute((const void*)mk_fwd, hipFuncAttributeMaxDynamicSharedMemorySize, LDS_BYTES) != hipSuccess) { fprintf(stderr, "kernel_launch: hipFuncSetAttribute failed\n"); grid = -1; return; }
        if (hipOccupancyMaxActiveBlocksPerMultiprocessor(&per_cu, (const void*)mk_fwd, NWAVES * 64, LDS_BYTES) != hipSuccess || per_cu < 1) { fprintf(stderr, "kernel_launch: occupancy query says %d blocks per CU\n", per_cu); grid = -1; (void)hipGetLastError(); return; }
        grid = cus;
    }
    if (grid < 0) return;
    (void)hipMemsetAsync((char*)d_ws + WS_CTL, 0, CTL_ZERO_BYTES, stream);
    Args a{};
    for (int i = 0; i < 11; ++i) a.in[i] = (const float*)d_in[i];
    a.out = (float*)d_out; a.ws = (unsigned char*)d_ws;
    constexpr int NSTEPS = 1 + NCHUNK * 6;
#if MK_MULTI
    for (int s = 0; s < NSTEPS; ++s) { a.st_lo = s; a.st_hi = s + 1; hipLaunchKernelGGL(mk_fwd, dim3(grid), dim3(NWAVES * 64), LDS_BYTES, stream, a); }
#else
    a.st_lo = 0; a.st_hi = NSTEPS;
    hipLaunchKernelGGL(mk_fwd, dim3(grid), dim3(NWAVES * 64), LDS_BYTES, stream, a);
#endif
}
```

```cpp
#include <hip/hip_runtime.h>
#include <cstdio>
#include <cstdint>

#define LAS __attribute__((address_space(3)))
#define GAS __attribute__((address_space(1)))
typedef unsigned short bf16_t;
typedef short bf16x8 __attribute__((ext_vector_type(8)));
typedef short s16x4 __attribute__((ext_vector_type(4)));
typedef float f32x4 __attribute__((ext_vector_type(4)));
typedef float f32x16 __attribute__((ext_vector_type(16)));
typedef unsigned u32x4 __attribute__((ext_vector_type(4)));
typedef unsigned u32x2 __attribute__((ext_vector_type(2)));
typedef float f32x2_t __attribute__((ext_vector_type(2)));
typedef __bf16 bf16x2_t __attribute__((ext_vector_type(2)));

constexpr int DM = 1024, INW = 6656, NTOK = 65536, CHT = 32768  , NCHUNK = 2;
constexpr float RMS_EPS = 1e-6f;
constexpr float LOG2E = 1.4426950408889634f;
constexpr float QSCALE = 0.125f * LOG2E;

__device__ __forceinline__ unsigned cvtpk(float lo, float hi) { f32x2_t v = {lo, hi}; bf16x2_t b = __builtin_convertvector(v, bf16x2_t); return __builtin_bit_cast(unsigned, b); }
__device__ __forceinline__ float bf_lo(unsigned u) { return __uint_as_float(u << 16); }
__device__ __forceinline__ float bf_hi(unsigned u) { return __uint_as_float(u & 0xffff0000u); }
__device__ __forceinline__ float fexp(float x) { return __builtin_amdgcn_exp2f(x * LOG2E); }
__device__ __forceinline__ float silu_f(float v) { return v * __builtin_amdgcn_rcpf(1.f + fexp(-v)); }

namespace pg8 {
constexpr int BM = 256, BK = 64, HALF = 128, HTB = HALF * BK * 2, STAGE_BYTES = 8 * HTB, NXCD = 8, WGM = 8;
__host__ __device__ __forceinline__ int lds_byte(int r, int c) { const int st = (r >> 4) * 2 + (c >> 5), rr = r & 15, cc = c & 31, ob = rr * 64 + cc * 2; return st * 1024 + (ob ^ (((ob >> 9) & 1) << 5)); }
__host__ __device__ __forceinline__ void stage_rc(int b, int& R, int& C) { const int st = b / 1024, sb = b % 1024, swz = sb ^ (((sb >> 9) & 1) << 5); R = (st >> 1) * 16 + swz / 64; C = (st & 1) * 32 + (swz % 64) / 2; }
__host__ __device__ __forceinline__ int perm32(int rho) { const int n = rho >> 4, i = rho & 15; return 8 * (i >> 2) + 4 * n + (i & 3); }

struct Unit { int pm, pn; };
struct Gemm { const bf16_t* A; const bf16_t* Bt; int lda, ldb, K, a_pn_step; };

struct StaticOrder {
    int nM, nN, nwg, G, c;
    __device__ void init(int M, int N, int G_, int c_) { nM = M / BM; nN = N / BM; nwg = nM * nN; G = G_; c = c_; }
    __device__ bool next(int i, Unit& u) const {
        const long L = (long)i * G + c; if (L >= nwg) return false;
        int wgid = (int)L; { const int q = nwg / NXCD, r = nwg % NXCD, xcd = wgid % NXCD, off = wgid / NXCD; wgid = (xcd < r ? xcd * (q + 1) : r * (q + 1) + (xcd - r) * q) + off; }
        const int nig = WGM * nN, gid = wgid / nig, fm = gid * WGM, gsz = (nM - fm) < WGM ? (nM - fm) : WGM;
        u.pm = fm + ((wgid % nig) % gsz); u.pn = (wgid % nig) / gsz; return true;
    }
};

template <class Epi, class Sched, bool ALIGN_EPI, bool SP2>
__device__ __forceinline__ void gemm_phase(LAS unsigned char* lds, const Gemm g, const Sched& S, const Epi& E) {
    int tid_ = threadIdx.x; asm volatile("" : "+v"(tid_));
    const int tid = tid_, wid = __builtin_amdgcn_readfirstlane(tid >> 6), lane = tid & 63, wr = wid >> 2, wc = wid & 3, fr = lane & 15, fq = lane >> 4;
    const int K = g.K, nt = K / BK;
    unsigned voffA[2], voffB[2];
#pragma unroll
    for (int i = 0; i < 2; ++i) { int R, C; stage_rc(tid * 16 + i * 8192, R, C); const int Rb = Epi::PERM ? ((R & ~31) + perm32(R & 31)) : R;
        voffA[i] = (unsigned)(R * g.lda + C) * 2u; voffB[i] = (unsigned)(Rb * g.ldb + C) * 2u; }
    const size_t kstep = (size_t)(BK * 2);
    const size_t hstepA = (size_t)HALF * g.lda * 2, hstepB = (size_t)HALF * g.ldb * 2;
    const size_t tstepA = 2 * hstepA, tstepB = 2 * hstepB, pnstepA = (size_t)g.a_pn_step * 2;
    const unsigned ldsw = (unsigned)wid * 1024u;
    const int aoff = lds_byte(wr * 64 + fr, fq * 8), boff = lds_byte(wc * 32 + fr, fq * 8);
#define PG8_SA(b, h) (((b) * 2 + (h)) * HTB)
#define PG8_SB(b, h) ((4 + (b) * 2 + (h)) * HTB)
#define PG8_STAGE(bufoff, gbase, voff) do { _Pragma("unroll") for (int _i = 0; _i < 2; ++_i) \
        __builtin_amdgcn_global_load_lds((const unsigned*)((const char*)(gbase) + (voff)[_i]), (LAS unsigned*)(lds + (bufoff) + ldsw + _i * 8192), 16, 0, 0); } while (0)
#define PG8_LDA(dst, b, h) do { _Pragma("unroll") for (int m = 0; m < 4; ++m) _Pragma("unroll") for (int k = 0; k < 2; ++k) dst[m][k] = *(const LAS bf16x8*)(lds + PG8_SA(b, h) + aoff + m * 2048 + k * 1024); } while (0)
#define PG8_LDB(dst, b, h) do { _Pragma("unroll") for (int n = 0; n < 2; ++n) _Pragma("unroll") for (int k = 0; k < 2; ++k) dst[n][k] = *(const LAS bf16x8*)(lds + PG8_SB(b, h) + boff + n * 2048 + k * 1024); } while (0)
#define PG8_MMA(ai, bj, At, Bt) do { __builtin_amdgcn_s_setprio(1); _Pragma("unroll") for (int m = 0; m < 4; ++m) _Pragma("unroll") for (int n = 0; n < 2; ++n) _Pragma("unroll") for (int k = 0; k < 2; ++k) \
        acc[ai][bj][m][n] = __builtin_amdgcn_mfma_f32_16x16x32_bf16(Bt[n][k], At[m][k], acc[ai][bj][m][n], 0, 0, 0); __builtin_amdgcn_s_setprio(0); } while (0)
#define PG8_WAIT_V(n) asm volatile("s_waitcnt vmcnt(" #n ")" ::: "memory")
#define PG8_WAIT_L(n) asm volatile("s_waitcnt lgkmcnt(" #n ")" ::: "memory")
#define PG8_BAR __builtin_amdgcn_s_barrier()
#define PG8_SCHED __builtin_amdgcn_sched_barrier(0)
    Unit cur, nxt; int ui = 0;
    if (!S.next(0, cur)) return;
    f32x4 acc[2][2][4][2];
#pragma unroll
    for (int a = 0; a < 2; ++a)
#pragma unroll
        for (int b = 0; b < 2; ++b)
#pragma unroll
            for (int m = 0; m < 4; ++m)
#pragma unroll
                for (int n = 0; n < 2; ++n) acc[a][b][m][n] = (f32x4){0.f, 0.f, 0.f, 0.f};
    bf16x8 At[4][2], B0[2][2], B1[2][2];
    const char* cA = (const char*)g.A + (size_t)cur.pm * tstepA + (size_t)cur.pn * pnstepA; const char* cB = (const char*)g.Bt + (size_t)cur.pn * tstepB;
    if constexpr (SP2) {
        PG8_STAGE(PG8_SB(0, 0), cB, voffB); PG8_STAGE(PG8_SB(0, 1), cB + hstepB, voffB); PG8_STAGE(PG8_SA(0, 0), cA, voffA); PG8_STAGE(PG8_SA(0, 1), cA + hstepA, voffA);
        if (wr == 1) PG8_BAR;
        PG8_WAIT_V(2); PG8_BAR;
        PG8_STAGE(PG8_SB(1, 0), cB + kstep, voffB); PG8_STAGE(PG8_SA(1, 0), cA + kstep, voffA); PG8_STAGE(PG8_SB(1, 1), cB + hstepB + kstep, voffB);
        PG8_WAIT_V(6); PG8_BAR;
    } else {
        PG8_STAGE(PG8_SB(0, 0), cB, voffB); PG8_STAGE(PG8_SA(0, 0), cA, voffA); PG8_STAGE(PG8_SB(0, 1), cB + hstepB, voffB); PG8_STAGE(PG8_SA(0, 1), cA + hstepA, voffA);
        if (wr == 1) PG8_BAR;
        PG8_WAIT_V(4); PG8_BAR;
        PG8_STAGE(PG8_SB(1, 0), cB + kstep, voffB); PG8_STAGE(PG8_SA(1, 0), cA + kstep, voffA); PG8_STAGE(PG8_SB(1, 1), cB + hstepB + kstep, voffB);
        PG8_WAIT_V(6); PG8_BAR;
    }
    for (;;) {
        const bool has_next = S.next(ui + 1, nxt);
        const char* nA = has_next ? (const char*)g.A + (size_t)nxt.pm * tstepA + (size_t)nxt.pn * pnstepA : cA; const char* nB = has_next ? (const char*)g.Bt + (size_t)nxt.pn * tstepB : cB;
        for (int t = 0; t < nt; t += 2) {
            if constexpr (Epi::HAS_MID) { if (t == (nt >> 1)) E.mid(acc, cur, wr, wc, fr, fq); }
            const bool last = (t == nt - 2);
            const char* a1 = cA + (size_t)(t + 1) * kstep;
            const char* a2 = last ? nA : cA + (size_t)(t + 2) * kstep; const char* b2 = last ? nB : cB + (size_t)(t + 2) * kstep;
            const char* a3 = a2 + kstep; const char* b3 = b2 + kstep;
            if constexpr (SP2) {
            PG8_LDB(B0, 0, 0); PG8_LDB(B1, 0, 1); PG8_SCHED; PG8_LDA(At, 0, 0); PG8_STAGE(PG8_SA(1, 1), a1 + hstepA, voffA);
            PG8_WAIT_V(8); PG8_WAIT_L(0); PG8_BAR; PG8_MMA(0, 0, At, B0); PG8_MMA(0, 1, At, B1); PG8_BAR; PG8_SCHED;
            PG8_LDA(At, 0, 1); PG8_STAGE(PG8_SB(0, 0), b2, voffB); PG8_STAGE(PG8_SB(0, 1), b2 + hstepB, voffB); PG8_STAGE(PG8_SA(0, 0), a2, voffA);
            PG8_WAIT_V(8); PG8_WAIT_L(0); PG8_BAR; PG8_MMA(1, 0, At, B0); PG8_MMA(1, 1, At, B1); PG8_BAR; PG8_SCHED;
            PG8_LDB(B0, 1, 0); PG8_LDB(B1, 1, 1); PG8_SCHED; PG8_LDA(At, 1, 0); PG8_STAGE(PG8_SA(0, 1), a2 + hstepA, voffA);
            PG8_WAIT_V(8); PG8_WAIT_L(0); PG8_BAR; PG8_MMA(0, 0, At, B0); PG8_MMA(0, 1, At, B1); PG8_BAR; PG8_SCHED;
            PG8_LDA(At, 1, 1); PG8_STAGE(PG8_SB(1, 0), b3, voffB); PG8_STAGE(PG8_SB(1, 1), b3 + hstepB, voffB); PG8_STAGE(PG8_SA(1, 0), a3, voffA);
            PG8_WAIT_V(8); PG8_WAIT_L(0); PG8_BAR; PG8_MMA(1, 0, At, B0); PG8_MMA(1, 1, At, B1); PG8_BAR; PG8_SCHED;
            } else {
            PG8_LDB(B0, 0, 0); PG8_SCHED; PG8_LDA(At, 0, 0); PG8_STAGE(PG8_SA(1, 1), a1 + hstepA, voffA);
            PG8_WAIT_L(8); PG8_BAR; PG8_WAIT_L(0); PG8_MMA(0, 0, At, B0); PG8_BAR; PG8_SCHED;
            PG8_LDB(B1, 0, 1); PG8_STAGE(PG8_SB(0, 0), b2, voffB);
            PG8_BAR; PG8_WAIT_L(0); PG8_MMA(0, 1, At, B1); PG8_BAR;
            PG8_LDA(At, 0, 1); PG8_STAGE(PG8_SA(0, 0), a2, voffA);
            PG8_BAR; PG8_WAIT_L(0); PG8_MMA(1, 0, At, B0); PG8_BAR; PG8_SCHED;
            PG8_STAGE(PG8_SB(0, 1), b2 + hstepB, voffB);
            PG8_WAIT_V(6); PG8_BAR; PG8_MMA(1, 1, At, B1); PG8_BAR;
            PG8_LDB(B0, 1, 0); PG8_SCHED; PG8_LDA(At, 1, 0); PG8_STAGE(PG8_SA(0, 1), a2 + hstepA, voffA);
            PG8_WAIT_L(8); PG8_BAR; PG8_WAIT_L(0); PG8_MMA(0, 0, At, B0); PG8_BAR; PG8_SCHED;
            PG8_LDB(B1, 1, 1); PG8_STAGE(PG8_SB(1, 0), b3, voffB);
            PG8_BAR; PG8_WAIT_L(0); PG8_MMA(0, 1, At, B1); PG8_BAR;
            PG8_LDA(At, 1, 1); PG8_STAGE(PG8_SA(1, 0), a3, voffA);
            PG8_BAR; PG8_WAIT_L(0); PG8_MMA(1, 0, At, B0); PG8_BAR; PG8_SCHED;
            PG8_STAGE(PG8_SB(1, 1), b3 + hstepB, voffB);
            PG8_WAIT_V(6); PG8_BAR; PG8_MMA(1, 1, At, B1); PG8_BAR;
            }
        }
        if constexpr (ALIGN_EPI) { if (wr == 0) PG8_BAR; }
        if constexpr (!Epi::AFTER_DRAIN) { E(acc, cur, wr, wc, fr, fq); }
        if (!has_next) break;
#pragma unroll
        for (int a = 0; a < 2; ++a)
#pragma unroll
            for (int b = 0; b < 2; ++b)
#pragma unroll
                for (int m = 0; m < 4; ++m)
#pragma unroll
                    for (int n = 0; n < 2; ++n) acc[a][b][m][n] = (f32x4){0.f, 0.f, 0.f, 0.f};
        cur = nxt; cA = nA; cB = nB; ++ui;
        if constexpr (ALIGN_EPI) { if (wr == 1) PG8_BAR; }
    }
    PG8_WAIT_V(0);
    if constexpr (!ALIGN_EPI) { if (wr == 0) PG8_BAR; }
    PG8_BAR;
    if constexpr (Epi::AFTER_DRAIN) { E.fused(acc, cur, wr, wc, fr, fq, lds, wid, lane); }
#undef PG8_SA
#undef PG8_SB
#undef PG8_STAGE
#undef PG8_LDA
#undef PG8_LDB
#undef PG8_MMA
#undef PG8_WAIT_V
#undef PG8_WAIT_L
#undef PG8_BAR
#undef PG8_SCHED
}

struct EpiZ {
    static constexpr bool PERM = true, AFTER_DRAIN = false, HAS_MID = false;
    bf16_t *U, *A2, *Q, *KT, *VT, *RHO, *GA; const float *rstd, *pscale, *ropec, *ropes; int S, pad;
    __device__ __forceinline__ void operator()(const f32x4 (&acc)[2][2][4][2], const Unit& u, int wr, int wc, int fr, int fq) const {
        { int t_ = threadIdx.x; asm volatile("" : "+v"(t_)); fr = t_ & 15; fq = (t_ >> 4) & 3; }
        const int pn = u.pn, rowb = u.pm * BM + wr * 64 + fr, cl = wc * 32 + 8 * fq;
        float rs[2][4];
#pragma unroll
        for (int ai = 0; ai < 2; ++ai)
#pragma unroll
            for (int m = 0; m < 4; ++m) rs[ai][m] = rstd[rowb + ai * HALF + m * 16];
        if (pn < 4 || pn == 13) {
#pragma unroll
            for (int ai = 0; ai < 2; ++ai)
#pragma unroll
                for (int m = 0; m < 4; ++m) { const int r = rowb + ai * HALF + m * 16; const float s = rs[ai][m];
#pragma unroll
                    for (int bj = 0; bj < 2; ++bj) { const f32x4 v0 = acc[ai][bj][m][0] * s, v1 = acc[ai][bj][m][1] * s;
                        u32x4 w; w.x = cvtpk(v0[0], v0[1]); w.y = cvtpk(v0[2], v0[3]); w.z = cvtpk(v1[0], v1[1]); w.w = cvtpk(v1[2], v1[3]);
                        bf16_t* dst;
                        if (pn < 4) dst = U + (size_t)r * DM + pn * BM + bj * HALF + cl;
                        else { const int hk = bj * 2 + (wc >> 1), dh = wc & 1; dst = VT + ((size_t)(((r >> 6) * 4 + hk) * 2 + dh) * 64 + (r & 63)) * 32 + fq * 8; }
                        *(u32x4*)dst = w; } }
        } else if (pn < 8 || (pn >= 14 && pn < 18)) {
            const bool pg = pn < 8; const int cb = pg ? (pn - 4) * BM : (pn - 14) * BM;
            f32x4 ps[2][2];
#pragma unroll
            for (int bj = 0; bj < 2; ++bj)
#pragma unroll
                for (int n = 0; n < 2; ++n) ps[bj][n] = pg ? *(const f32x4*)(pscale + cb + bj * HALF + cl + 4 * n) : (f32x4){1.f, 1.f, 1.f, 1.f};
#pragma unroll
            for (int ai = 0; ai < 2; ++ai)
#pragma unroll
                for (int m = 0; m < 4; ++m) { const int r = rowb + ai * HALF + m * 16; const float s = rs[ai][m];
#pragma unroll
                    for (int bj = 0; bj < 2; ++bj) { f32x4 v0 = acc[ai][bj][m][0] * s, v1 = acc[ai][bj][m][1] * s;
#pragma unroll
                        for (int e = 0; e < 4; ++e) { v0[e] = silu_f(v0[e]) * ps[bj][0][e]; v1[e] = silu_f(v1[e]) * ps[bj][1][e]; }
                        u32x4 w; w.x = cvtpk(v0[0], v0[1]); w.y = cvtpk(v0[2], v0[3]); w.z = cvtpk(v1[0], v1[1]); w.w = cvtpk(v1[2], v1[3]);
                        *(u32x4*)(A2 + (size_t)r * 2048 + (pg ? 0 : 1024) + cb + bj * HALF + cl) = w; } }
        } else if (pn < 13) {
            const bool isq = pn < 12; const int i0 = 16 * (wc & 1) + 4 * fq; const float sc = isq ? QSCALE : 1.f;
#pragma unroll
            for (int ai = 0; ai < 2; ++ai)
#pragma unroll
                for (int m = 0; m < 4; ++m) { const int r = rowb + ai * HALF + m * 16; const float s = rs[ai][m] * sc; const int pos = r & (S - 1);
                    const f32x4 cs = *(const f32x4*)(ropec + pos * 32 + i0), sn = *(const f32x4*)(ropes + pos * 32 + i0);
#pragma unroll
                    for (int bj = 0; bj < 2; ++bj) { const f32x4 x1 = acc[ai][bj][m][0] * s, x2 = acc[ai][bj][m][1] * s;
                        const f32x4 o1 = x1 * cs - x2 * sn, o2 = x2 * cs + x1 * sn;
                        u32x4 w; w.x = cvtpk(o1[0], o1[1]); w.y = cvtpk(o1[2], o1[3]); w.z = cvtpk(o2[0], o2[1]); w.w = cvtpk(o2[2], o2[3]);
                        bf16_t* dst;
                        if (isq) dst = Q + (size_t)r * DM + (pn - 8) * BM + bj * HALF + cl;
                        else { const int hk = bj * 2 + (wc >> 1), ch = 4 * (wc & 1) + fq; dst = KT + ((size_t)(((r >> 6) * 4 + hk) * 8 + ch) * 64 + (r & 63)) * 8; }
                        *(u32x4*)dst = w; } }
        } else {
            const int cb = (pn - 18) * HALF;
#pragma unroll
            for (int ai = 0; ai < 2; ++ai)
#pragma unroll
                for (int m = 0; m < 4; ++m) { const int r = rowb + ai * HALF + m * 16; const float s = rs[ai][m];
#pragma unroll
                    for (int bj = 0; bj < 2; ++bj) { const f32x4 a = acc[ai][bj][m][0] * s, b = acc[ai][bj][m][1] * s; float ga[4], rho[4];
#pragma unroll
                        for (int e = 0; e < 4; ++e) { const float ea = fexp(-fminf(fmaxf(a[e], -30.f), 30.f)), eb = fexp(-fminf(fmaxf(b[e], -30.f), 30.f));
                            ga[e] = __builtin_amdgcn_rcpf(1.f + eb); rho[e] = (1.f + eb) * __builtin_amdgcn_rcpf(1.f + ea); }
                        const size_t off = (size_t)r * DM + cb + bj * 64 + wc * 16 + fq * 4;
                        u32x2 wr_, wg_; wr_.x = cvtpk(rho[0], rho[1]); wr_.y = cvtpk(rho[2], rho[3]); wg_.x = cvtpk(ga[0], ga[1]); wg_.y = cvtpk(ga[2], ga[3]);
                        *(u32x2*)(RHO + off) = wr_; *(u32x2*)(GA + off) = wg_; } }
        }
    }
};
struct EpiPB {
    static constexpr bool PERM = true, AFTER_DRAIN = false, HAS_MID = false;
    bf16_t* A2;
    __device__ __forceinline__ void operator()(const f32x4 (&acc)[2][2][4][2], const Unit& u, int wr, int wc, int fr, int fq) const {
        { int t_ = threadIdx.x; asm volatile("" : "+v"(t_)); fr = t_ & 15; fq = (t_ >> 4) & 3; }
        const int rowb = u.pm * BM + wr * 64 + fr, col0 = u.pn * BM + wc * 32 + 8 * fq;
#pragma unroll
        for (int ai = 0; ai < 2; ++ai)
#pragma unroll
            for (int m = 0; m < 4; ++m) { bf16_t* rowp = A2 + (size_t)(rowb + ai * HALF + m * 16) * 2048 + col0;
#pragma unroll
                for (int bj = 0; bj < 2; ++bj) { const u32x4 g = *(const u32x4*)(rowp + bj * HALF); const f32x4 v0 = acc[ai][bj][m][0], v1 = acc[ai][bj][m][1];
                    u32x4 w; w.x = cvtpk(v0[0] * bf_lo(g.x), v0[1] * bf_hi(g.x)); w.y = cvtpk(v0[2] * bf_lo(g.y), v0[3] * bf_hi(g.y));
                    w.z = cvtpk(v1[0] * bf_lo(g.z), v1[1] * bf_hi(g.z)); w.w = cvtpk(v1[2] * bf_lo(g.w), v1[3] * bf_hi(g.w));
                    *(u32x4*)(rowp + bj * HALF) = w; }
                if (m & 1) asm volatile("" ::: "memory"); }
    }
};
struct EpiM {
    static constexpr bool PERM = true, AFTER_DRAIN = false, HAS_MID = true;
    const bf16_t *RHO, *GA; bf16_t* Mo;
    __device__ __forceinline__ void mid(f32x4 (&acc)[2][2][4][2], const Unit& u, int wr, int wc, int fr, int fq) const {
        { int t_ = threadIdx.x; asm volatile("" : "+v"(t_)); fr = t_ & 15; fq = (t_ >> 4) & 3; }
        const int rowb = u.pm * BM + wr * 64 + fr, col0 = u.pn * BM + wc * 32 + 8 * fq;
#pragma unroll
        for (int ai = 0; ai < 2; ++ai)
#pragma unroll
            for (int m = 0; m < 4; ++m) { const bf16_t* rowp = RHO + (size_t)(rowb + ai * HALF + m * 16) * DM + col0;
#pragma unroll
                for (int bj = 0; bj < 2; ++bj) { const u32x4 g = *(const u32x4*)(rowp + bj * HALF);
                    acc[ai][bj][m][0] *= (f32x4){bf_lo(g.x), bf_hi(g.x), bf_lo(g.y), bf_hi(g.y)}; acc[ai][bj][m][1] *= (f32x4){bf_lo(g.z), bf_hi(g.z), bf_lo(g.w), bf_hi(g.w)}; }
                if (m & 1) asm volatile("" ::: "memory"); }
    }
    __device__ __forceinline__ void operator()(const f32x4 (&acc)[2][2][4][2], const Unit& u, int wr, int wc, int fr, int fq) const {
        { int t_ = threadIdx.x; asm volatile("" : "+v"(t_)); fr = t_ & 15; fq = (t_ >> 4) & 3; }
        const int rowb = u.pm * BM + wr * 64 + fr, col0 = u.pn * BM + wc * 32 + 8 * fq;
#pragma unroll
        for (int ai = 0; ai < 2; ++ai)
#pragma unroll
            for (int m = 0; m < 4; ++m) { const size_t ro = (size_t)(rowb + ai * HALF + m * 16) * DM + col0;
#pragma unroll
                for (int bj = 0; bj < 2; ++bj) { const u32x4 g = *(const u32x4*)(GA + ro + bj * HALF); const f32x4 v0 = acc[ai][bj][m][0], v1 = acc[ai][bj][m][1];
                    u32x4 w; w.x = cvtpk(v0[0] * bf_lo(g.x), v0[1] * bf_hi(g.x)); w.y = cvtpk(v0[2] * bf_lo(g.y), v0[3] * bf_hi(g.y));
                    w.z = cvtpk(v1[0] * bf_lo(g.z), v1[1] * bf_hi(g.z)); w.w = cvtpk(v1[2] * bf_lo(g.w), v1[3] * bf_hi(g.w));
                    *(u32x4*)(Mo + ro + bj * HALF) = w; }
                if (m & 1) asm volatile("" ::: "memory"); }
    }
};
struct EpiF32 {
    static constexpr bool PERM = false, AFTER_DRAIN = false, HAS_MID = false;
    float* C; int ldc, pad;
    __device__ __forceinline__ void operator()(const f32x4 (&acc)[2][2][4][2], const Unit& u, int wr, int wc, int fr, int fq) const {
        { int t_ = threadIdx.x; asm volatile("" : "+v"(t_)); fr = t_ & 15; fq = (t_ >> 4) & 3; }
        const int row0 = u.pm * BM + wr * 64 + fr, col0 = u.pn * BM + wc * 32 + 4 * fq;
#pragma unroll
        for (int ai = 0; ai < 2; ++ai)
#pragma unroll
            for (int m = 0; m < 4; ++m) { float* rowp = C + (size_t)(row0 + ai * HALF + m * 16) * ldc + col0;
#pragma unroll
                for (int bj = 0; bj < 2; ++bj)
#pragma unroll
                    for (int n = 0; n < 2; ++n) *(f32x4*)(rowp + bj * HALF + n * 16) = acc[ai][bj][m][n]; }
    }
};
}

namespace att {
constexpr int SLOT = 8192, LDS_K = 0, LDS_V = 5 * SLOT, LDS_WS = 10 * SLOT, LDS_OST = LDS_WS + 8 * 256, LDS_END = LDS_OST + 8 * 4096;
__device__ __forceinline__ int crow(int r, int hi) { return (r & 3) + 8 * (r >> 2) + 4 * hi; }
__device__ __forceinline__ s16x4 vtr(const LAS unsigned char* p) { typedef short v4i16_t __attribute__((ext_vector_type(4))); return __builtin_bit_cast(s16x4, __builtin_amdgcn_ds_read_tr16_b64_v4i16((LAS v4i16_t*)p)); }

template <int THRL>
__device__ __forceinline__ void attn_unit(LAS unsigned char* shm, int row0  , int S, int hk, int qb,
                                          const bf16_t* Q, const bf16_t* KT, const bf16_t* VT, bf16_t* A2, const float* sink) {
    int tid_ = threadIdx.x; asm volatile("" : "+v"(tid_));
    const int tid = tid_, lane = tid & 63, r32 = lane & 31, hi = lane >> 5, wid = __builtin_amdgcn_readfirstlane(tid >> 6);
    const int hq = hk * 4 + (wid & 3), qh = 2 * qb + (wid >> 2), ntile = S >> 6, T0 = row0 >> 6;
#pragma unroll
    for (int s = 0; s < 5; ++s) { const int tile = qb - 2 + s;
        if (tile >= 0 && tile < ntile) {
            const u32x4 kv = *(const u32x4*)((const char*)KT + ((size_t)((T0 + tile) * 4 + hk) << 13) + tid * 16);
            const u32x4 vv = *(const u32x4*)((const char*)VT + ((size_t)((T0 + tile) * 4 + hk) << 13) + tid * 16);
            *(LAS u32x4*)(shm + LDS_K + s * SLOT + tid * 16) = kv; *(LAS u32x4*)(shm + LDS_V + s * SLOT + tid * 16) = vv; } }
    const size_t qrow = (size_t)(row0 + qh * 32 + r32);
    bf16x8 qr[4];
#pragma unroll
    for (int s = 0; s < 4; ++s) qr[s] = *(const bf16x8*)(Q + qrow * DM + hq * 64 + s * 16 + hi * 8);
    LAS float* wsf = (LAS float*)(shm + LDS_WS) + wid * 64;
    float mhat = sink[hq] * LOG2E, l_reg = (hi == 0) ? 1.f : 0.f;
    f32x16 o[2]; o[0] = f32x16{}; o[1] = f32x16{};
    __syncthreads();
    const LAS unsigned char* vb0 = shm + LDS_V + ((lane >> 4) & 1) * 32 + (lane & 3) * 8 + (4 * hi + ((lane & 15) >> 2)) * 64;
    for (int i = 0; i < 9; ++i) {
        const int ht = qh - 4 + i;
        if (ht < 0 || ht >= 2 * ntile) continue;
        const int slot = (ht >> 1) - (qb - 2), half = ht & 1;
        const LAS unsigned char* kp = shm + LDS_K + slot * SLOT + half * 512 + hi * 1024 + r32 * 16;
        f32x16 p;
#pragma unroll
        for (int r = 0; r < 16; ++r) p[r] = -mhat;
#pragma unroll
        for (int s = 0; s < 4; ++s) { const bf16x8 kf = *(const LAS bf16x8*)(kp + s * 2048); p = __builtin_amdgcn_mfma_f32_32x32x16_bf16(kf, qr[s], p, 0, 0, 0); }
        if (i == 0) {
#pragma unroll
            for (int r = 0; r < 16; ++r) if (crow(r, hi) < r32) p[r] = -INFINITY;
        }
        if (i == 8) {
#pragma unroll
            for (int r = 0; r < 16; ++r) if (crow(r, hi) > r32) p[r] = -INFINITY;
        }
        float rm = fmaxf(fmaxf(p[0], p[1]), fmaxf(p[2], p[3]));
#pragma unroll
        for (int r = 4; r < 16; r += 4) rm = fmaxf(rm, fmaxf(fmaxf(p[r], p[r + 1]), fmaxf(p[r + 2], p[r + 3])));
        { auto rr = __builtin_amdgcn_permlane32_swap(__float_as_uint(rm), __float_as_uint(rm), false, false); rm = fmaxf(__uint_as_float(rr[0]), __uint_as_float(rr[1])); }
        if (__any(rm > (float)THRL)) {
            const float dl = fmaxf(rm, 0.f); mhat += dl;
#pragma unroll
            for (int r = 0; r < 16; ++r) p[r] -= dl;
            const float f = __builtin_amdgcn_exp2f(-dl); l_reg *= f;
            if (hi == 0) wsf[r32] = f;
            asm volatile("s_waitcnt lgkmcnt(0)" ::: "memory");
#pragma unroll
            for (int r = 0; r < 16; ++r) { const float fr_ = wsf[crow(r, hi)]; o[0][r] *= fr_; o[1][r] *= fr_; }
            asm volatile("s_waitcnt lgkmcnt(0)" ::: "memory");
        }
        float sacc = 0.f;
#pragma unroll
        for (int r = 0; r < 16; ++r) { p[r] = __builtin_amdgcn_exp2f(p[r]); sacc += p[r]; }
        l_reg += sacc;
        u32x4 pw0, pw1;
        pw0.x = cvtpk(p[0], p[1]); pw0.y = cvtpk(p[2], p[3]); pw0.z = cvtpk(p[4], p[5]); pw0.w = cvtpk(p[6], p[7]);
        pw1.x = cvtpk(p[8], p[9]); pw1.y = cvtpk(p[10], p[11]); pw1.z = cvtpk(p[12], p[13]); pw1.w = cvtpk(p[14], p[15]);
        const bf16x8 pa0 = __builtin_bit_cast(bf16x8, pw0), pa1 = __builtin_bit_cast(bf16x8, pw1);
        const LAS unsigned char* vb = vb0 + slot * SLOT + half * 2048;
#pragma unroll
        for (int dh = 0; dh < 2; ++dh) {
            const s16x4 l0 = vtr(vb + dh * 4096), h0 = vtr(vb + dh * 4096 + 512), l1 = vtr(vb + dh * 4096 + 1024), h1 = vtr(vb + dh * 4096 + 1536);
            const bf16x8 v0 = (bf16x8){l0[0], l0[1], l0[2], l0[3], h0[0], h0[1], h0[2], h0[3]}, v1 = (bf16x8){l1[0], l1[1], l1[2], l1[3], h1[0], h1[1], h1[2], h1[3]};
            o[dh] = __builtin_amdgcn_mfma_f32_32x32x16_bf16(pa0, v0, o[dh], 0, 0, 0);
            o[dh] = __builtin_amdgcn_mfma_f32_32x32x16_bf16(pa1, v1, o[dh], 0, 0, 0);
        }
    }
    { auto rr = __builtin_amdgcn_permlane32_swap(__float_as_uint(l_reg), __float_as_uint(l_reg), false, false); l_reg = __uint_as_float(rr[0]) + __uint_as_float(rr[1]); }
    if (hi == 0) wsf[32 + r32] = l_reg;
    asm volatile("s_waitcnt lgkmcnt(0)" ::: "memory");
    LAS bf16_t* stg = (LAS bf16_t*)(shm + LDS_OST) + wid * 2048;
#pragma unroll
    for (int r = 0; r < 16; ++r) { const int orow = crow(r, hi); const float rl = __builtin_amdgcn_rcpf(wsf[32 + orow]);
        stg[orow * 64 + r32] = (bf16_t)(cvtpk(o[0][r] * rl, 0.f) & 0xffffu); stg[orow * 64 + 32 + r32] = (bf16_t)(cvtpk(o[1][r] * rl, 0.f) & 0xffffu); }
    asm volatile("s_waitcnt lgkmcnt(0)" ::: "memory");
    bf16_t* orow0 = A2 + (size_t)(row0 + qh * 32) * 2048 + 1024 + hq * 64;
#pragma unroll
    for (int i = 0; i < 4; ++i) { const int row = i * 8 + (lane >> 3), ch = lane & 7; const u32x4 v = *(const LAS u32x4*)(stg + row * 64 + ch * 8);
        bf16_t* gp = orow0 + (size_t)row * 2048 + ch * 8; const u32x4 g = *(const u32x4*)gp;
        u32x4 w; w.x = cvtpk(bf_lo(v.x) * bf_lo(g.x), bf_hi(v.x) * bf_hi(g.x)); w.y = cvtpk(bf_lo(v.y) * bf_lo(g.y), bf_hi(v.y) * bf_hi(g.y));
        w.z = cvtpk(bf_lo(v.z) * bf_lo(g.z), bf_hi(v.z) * bf_hi(g.z)); w.w = cvtpk(bf_lo(v.w) * bf_lo(g.w), bf_hi(v.w) * bf_hi(g.w));
        *(u32x4*)gp = w; }
    __syncthreads();
}
}

constexpr int NWAVES = 8;
#ifndef DUP_MASK
#define DUP_MASK 0
#endif
#ifndef MK_MULTI
#define MK_MULTI 0
#endif
constexpr size_t MiB = 1u << 20;
constexpr size_t WS_CTL = 0, CTL_ZERO_BYTES = 1 * MiB;
constexpr size_t WS_WIN = 1 * MiB, WS_WPG = 14 * MiB, WS_W2 = 15 * MiB, WS_WOUT = 19 * MiB, WS_ROPE = 21 * MiB, WS_RSTD = 23 * MiB;
constexpr size_t WS_A2 = 32 * MiB, WS_U = 160 * MiB, WS_Q = 224 * MiB, WS_KT = 288 * MiB, WS_VT = 304 * MiB, WS_RHO = 320 * MiB, WS_GA = 384 * MiB, WS_END = 448 * MiB;
constexpr size_t WS_M = WS_U;
constexpr int CW_BAR = 4096;
constexpr int RING_BYTES = 131072, LDSCTL_OFF = RING_BYTES, MISC_OFF = LDSCTL_OFF + 320, LDS_BYTES = 147456;
static_assert(att::LDS_END <= RING_BYTES, "attention scratch fits the ring");

typedef GAS unsigned gu32;
#define XB_TMO      128
#define XB_XCNT(j)  (256  + 64 * (j))
#define XB_XSUB(j)  (1280 + 64 * (j))
#define XB_XGEN(j)  (2304 + 64 * (j))
#define XB_TOP      3328
#define XB_TOPGEN   3392
#define XCD_BAR_WORDS 3456
#define XB_SPIN_CAP (1u << 18)
__device__ __forceinline__ unsigned xb_ld(unsigned* p)              { return __hip_atomic_load(p, __ATOMIC_RELAXED, __HIP_MEMORY_SCOPE_AGENT); }
__device__ __forceinline__ unsigned xb_add(unsigned* p, unsigned v) { return __hip_atomic_fetch_add(p, v, __ATOMIC_RELAXED, __HIP_MEMORY_SCOPE_AGENT); }
__device__ __forceinline__ unsigned xb_xcc_id() { return (unsigned)__builtin_amdgcn_s_getreg((3 << 11) | 20) & 0xFu; }
#define XB_SPIN(cond, bar) do { unsigned _sp = 0; while (cond) { __builtin_amdgcn_s_sleep(1); \
    if ((++_sp & 255u) == 0u) { if (xb_ld(&(bar)[XB_TMO])) break; if (_sp > XB_SPIN_CAP) { atomicAdd(&(bar)[XB_TMO], 1u); break; } } } } while (0)
struct XcdBarrier { unsigned* bar; unsigned x; volatile LAS unsigned* st; };
__device__ __forceinline__ XcdBarrier xcd_barrier_post(unsigned* bar, volatile LAS unsigned* st) {
    XcdBarrier b; b.bar = bar; b.x = xb_xcc_id(); b.st = st;
    if (threadIdx.x == 0) (void)xb_add(&bar[XB_XCNT(b.x)], 1u);
    return b;
}
__device__ __forceinline__ void xcd_barrier_complete(unsigned* bar, unsigned x, unsigned& nloc, unsigned& nx) {
    const unsigned G = gridDim.x * gridDim.y * gridDim.z;
    unsigned sum, cnt, mine, sp = 0u;
    for (;;) {
        sum = 0u; cnt = 0u; mine = 0u;
#pragma unroll
        for (unsigned j = 0; j < 16; ++j) { const unsigned c = xb_ld(&bar[XB_XCNT(j)]); sum += c; cnt += (c > 0u) ? 1u : 0u; mine = (j == x) ? c : mine; }
        if (sum == G) break;
        __builtin_amdgcn_s_sleep(1);
        if ((++sp & 255u) == 0u) { if (xb_ld(&bar[XB_TMO])) break; if (sp > XB_SPIN_CAP) { atomicAdd(&bar[XB_TMO], 1u); break; } }
    }
    nloc = mine > 0u ? mine : 1u; nx = cnt > 0u ? cnt : 1u;
}
__device__ __forceinline__ void xcd_barrier(const XcdBarrier& b) {
    asm volatile("s_waitcnt vmcnt(0)" ::: "memory");
    __syncthreads();
    if (threadIdx.x == 0) {
        unsigned* bar = b.bar;
        __builtin_amdgcn_s_waitcnt(0);
        unsigned nloc = b.st[0], nx = b.st[1];
        if (nloc == 0u) { xcd_barrier_complete(bar, b.x, nloc, nx); b.st[0] = nloc; b.st[1] = nx; }
        const unsigned old = xb_add(&bar[XB_XSUB(b.x)], 1u);
        const unsigned gen = old / nloc;
        if (old + 1u == (gen + 1u) * nloc) {
            __builtin_amdgcn_fence(__ATOMIC_RELEASE, "agent");
            asm volatile("s_waitcnt vmcnt(0)" ::: "memory");
            const unsigned og = xb_add(&bar[XB_TOP], 1u);
            const unsigned tg = og / nx;
            if (og + 1u == (tg + 1u) * nx) xb_add(&bar[XB_TOPGEN], 1u);
            else XB_SPIN(xb_ld(&bar[XB_TOPGEN]) == tg, bar);
            __builtin_amdgcn_fence(__ATOMIC_ACQUIRE, "agent");
            xb_add(&bar[XB_XGEN(b.x)], 1u);
            asm volatile("s_waitcnt vmcnt(0)" ::: "memory");
        } else {
            XB_SPIN(xb_ld(&bar[XB_XGEN(b.x)]) == gen, bar);
            __builtin_amdgcn_fence(__ATOMIC_ACQUIRE, "agent");
            asm volatile("s_waitcnt vmcnt(0)" ::: "memory");
        }
    }
    __syncthreads();
}

__device__ __forceinline__ float wave_sum(float v) {
#define WS_SWZ(o) v += __uint_as_float((unsigned)__builtin_amdgcn_ds_swizzle((int)__float_as_uint(v), 0x1f | ((o) << 10)))
    WS_SWZ(1); WS_SWZ(2); WS_SWZ(4); WS_SWZ(8); WS_SWZ(16);
#undef WS_SWZ
    auto rr = __builtin_amdgcn_permlane32_swap(__float_as_uint(v), __float_as_uint(v), false, false);
    return __uint_as_float(rr[0]) + __uint_as_float(rr[1]);
}
__device__ __forceinline__ int win_src_col(int n) {
    if (n < 2048) return n;
    if (n < 3328) { const int j = n & 63, base = n - j, i8 = j >> 3, w = j & 7; return base + ((w < 4) ? (4 * i8 + w) : (32 + 4 * i8 + (w - 4))); }
    if (n < 4608) return n;
    const int j = n - 4608, blk = j >> 3, w = j & 7; return 4608 + ((w < 4) ? (4 * blk + w) : (1024 + 4 * blk + (w - 4)));
}
template <bool WIN>
__device__ __forceinline__ void p0_transpose_item(const float* W, int N, const float* gk, bf16_t* WT, int ldt, int row_off, int col_off, LAS float* scr, int item, int lane) {
    const int nblk = N / 32, kb = item / nblk, nb = item % nblk, k0 = 64 * kb, n0 = 32 * nb;
    const int sc = WIN ? win_src_col(n0 + (lane & 31)) : (n0 + (lane & 31));
#pragma unroll 8
    for (int i = 0; i < 32; ++i) { const int kk = 2 * i + (lane >> 5); float v = W[(size_t)(k0 + kk) * N + sc]; if (WIN) v *= gk[k0 + kk]; scr[kk * 33 + (lane & 31)] = v; }
    asm volatile("s_waitcnt lgkmcnt(0)" ::: "memory");
    const int c = lane & 7;
#pragma unroll
    for (int j = 0; j < 4; ++j) { const int n = (lane >> 3) + 8 * j; const LAS float* s = scr + (8 * c) * 33 + n;
        u32x4 o; o.x = cvtpk(s[0 * 33], s[1 * 33]); o.y = cvtpk(s[2 * 33], s[3 * 33]); o.z = cvtpk(s[4 * 33], s[5 * 33]); o.w = cvtpk(s[6 * 33], s[7 * 33]);
        *(u32x4*)(WT + (size_t)(row_off + n0 + n) * ldt + col_off + k0 + 8 * c) = o; }
    asm volatile("s_waitcnt lgkmcnt(0)" ::: "memory");
}


__device__ __forceinline__ void p0_fold_item(const float* W, const float* Wg, const float* gk, bf16_t* WT, LAS float* scr, int item, int lane) {
    const int db = item & 7, kb = (item >> 3) & 15, g = item >> 7, k0 = 64 * kb, d0 = 32 * db;
    LAS float* sA = scr; LAS float* sB = scr + 64 * 33;
    float acc[32];
#pragma unroll
    for (int d = 0; d < 32; ++d) acc[d] = 0.f;
    for (int cc = 0; cc < 8; ++cc) {
#pragma unroll 8
        for (int i = 0; i < 32; ++i) { const int kk = 2 * i + (lane >> 5); sA[kk * 33 + (lane & 31)] = W[(size_t)(k0 + kk) * INW + g * 256 + cc * 32 + (lane & 31)]; }
#pragma unroll 8
        for (int i = 0; i < 16; ++i) { const int ci = 2 * i + (lane >> 5); sB[ci * 32 + (lane & 31)] = Wg[(size_t)g * 65536 + (size_t)(cc * 32 + ci) * 256 + d0 + (lane & 31)]; }
        asm volatile("s_waitcnt vmcnt(0) lgkmcnt(0)" ::: "memory");
#pragma unroll 4
        for (int ci = 0; ci < 32; ++ci) { const float a = sA[lane * 33 + ci];
#pragma unroll
            for (int d4 = 0; d4 < 8; ++d4) { const f32x4 b = *(const LAS f32x4*)(sB + ci * 32 + 4 * d4); acc[4 * d4] = fmaf(a, b.x, acc[4 * d4]); acc[4 * d4 + 1] = fmaf(a, b.y, acc[4 * d4 + 1]); acc[4 * d4 + 2] = fmaf(a, b.z, acc[4 * d4 + 2]); acc[4 * d4 + 3] = fmaf(a, b.w, acc[4 * d4 + 3]); } }
        asm volatile("s_waitcnt lgkmcnt(0)" ::: "memory");
    }
    const float gg = gk[k0 + lane];
#pragma unroll
    for (int d = 0; d < 32; ++d) sA[lane * 33 + d] = acc[d] * gg;
    asm volatile("s_waitcnt lgkmcnt(0)" ::: "memory");
    const int c = lane & 7;
#pragma unroll
    for (int j = 0; j < 4; ++j) { const int n = (lane >> 3) + 8 * j; const LAS float* sp = sA + (8 * c) * 33 + n;
        u32x4 o; o.x = cvtpk(sp[0 * 33], sp[1 * 33]); o.y = cvtpk(sp[2 * 33], sp[3 * 33]); o.z = cvtpk(sp[4 * 33], sp[5 * 33]); o.w = cvtpk(sp[6 * 33], sp[7 * 33]);
        *(u32x4*)(WT + (size_t)(g * 256 + d0 + n) * DM + k0 + 8 * c) = o; }
    asm volatile("s_waitcnt lgkmcnt(0)" ::: "memory");
}
template <int W>
__device__ __forceinline__ void pool_item(const bf16_t* U, bf16_t* A2, int tok, int cc, int S) {
    const int pos = tok & (S - 1), sb = tok - pos;
    u32x4 v[W];
#pragma unroll
    for (int i = 0; i < W; ++i) { int j = pos - W / 2 + i; j = j < 0 ? 0 : (j > S - 1 ? S - 1 : j); v[i] = *(const u32x4*)(U + (size_t)(sb + j) * DM + cc); }
    bf16_t* gp = A2 + (size_t)tok * 2048 + cc; const u32x4 g = *(const u32x4*)gp;
    float sm[8];
#pragma unroll
    for (int e = 0; e < 8; ++e) sm[e] = 0.f;
#pragma unroll
    for (int i = 0; i < W; ++i) { const int j = pos - W / 2 + i; const float ok = (j >= 0 && j < S) ? 1.f : 0.f;
        sm[0] = fmaf(ok, bf_lo(v[i].x), sm[0]); sm[1] = fmaf(ok, bf_hi(v[i].x), sm[1]); sm[2] = fmaf(ok, bf_lo(v[i].y), sm[2]); sm[3] = fmaf(ok, bf_hi(v[i].y), sm[3]);
        sm[4] = fmaf(ok, bf_lo(v[i].z), sm[4]); sm[5] = fmaf(ok, bf_hi(v[i].z), sm[5]); sm[6] = fmaf(ok, bf_lo(v[i].w), sm[6]); sm[7] = fmaf(ok, bf_hi(v[i].w), sm[7]); }
    int wl = pos - W / 2, wh = wl + W; wl = wl < 0 ? 0 : wl; wh = wh > S ? S : wh;
    const float ic = 1.f / (float)(wh - wl); const u32x4 sv = v[W / 2];
    u32x4 o; o.x = cvtpk((sm[0] * ic - bf_lo(sv.x)) * bf_lo(g.x), (sm[1] * ic - bf_hi(sv.x)) * bf_hi(g.x)); o.y = cvtpk((sm[2] * ic - bf_lo(sv.y)) * bf_lo(g.y), (sm[3] * ic - bf_hi(sv.y)) * bf_hi(g.y));
    o.z = cvtpk((sm[4] * ic - bf_lo(sv.z)) * bf_lo(g.z), (sm[5] * ic - bf_hi(sv.z)) * bf_hi(g.z)); o.w = cvtpk((sm[6] * ic - bf_lo(sv.w)) * bf_lo(g.w), (sm[7] * ic - bf_hi(sv.w)) * bf_hi(g.w));
    *(u32x4*)gp = o;
}

struct Args { const float* in[11]; float* out; unsigned char* ws; int st_lo, st_hi; };

__global__ void __launch_bounds__(NWAVES * 64, 2) mk_fwd(Args args) {
    extern __shared__ __attribute__((aligned(16))) unsigned char lds_raw[];
    LAS unsigned char* lds = (LAS unsigned char*)lds_raw;
    volatile LAS unsigned* MISC = (volatile LAS unsigned*)(lds + MISC_OFF);
    const int tid = threadIdx.x, lane = tid & 63, wave = __builtin_amdgcn_readfirstlane(tid >> 6);
    const int G = gridDim.x, bx = blockIdx.x;
    const int vcu = (G % 8 == 0) ? (bx % 8) * (G / 8) + bx / 8 : bx;
    unsigned char* ws = args.ws;
    const float* x_prompt = args.in[0]; const float* x_sample = args.in[1]; const float* norm_pre = args.in[2]; const float* w_in = args.in[3]; const float* w_pg = args.in[4];
    const float* pool_scale = args.in[5]; const float* w_pp = args.in[6]; const float* sink = args.in[7]; const float* w_ap = args.in[8]; const float* w_out = args.in[9]; const float* norm_post = args.in[10];
    bf16_t* WIN_T = (bf16_t*)(ws + WS_WIN); bf16_t* WPG_T = (bf16_t*)(ws + WS_WPG); bf16_t* W2_T = (bf16_t*)(ws + WS_W2); bf16_t* WOUT_T = (bf16_t*)(ws + WS_WOUT);
    float* ROPEC = (float*)(ws + WS_ROPE); float* ROPES = ROPEC + 8192 * 32; float* RSTD = (float*)(ws + WS_RSTD);
    bf16_t* A2 = (bf16_t*)(ws + WS_A2); bf16_t* U = (bf16_t*)(ws + WS_U); bf16_t* Qb = (bf16_t*)(ws + WS_Q); bf16_t* KT = (bf16_t*)(ws + WS_KT); bf16_t* VT = (bf16_t*)(ws + WS_VT);
    bf16_t* RHO = (bf16_t*)(ws + WS_RHO); bf16_t* GA = (bf16_t*)(ws + WS_GA); bf16_t* Mb = (bf16_t*)(ws + WS_M);

    for (int u = tid; u < (LDS_BYTES - LDSCTL_OFF) / 4; u += NWAVES * 64) ((LAS unsigned*)(lds + LDSCTL_OFF))[u] = 0u;
    __syncthreads();
    XcdBarrier bar; bar.bar = (unsigned*)(ws + WS_CTL) + CW_BAR; bar.x = 0; bar.st = nullptr;
    if (!MK_MULTI) bar = xcd_barrier_post((unsigned*)(ws + WS_CTL) + CW_BAR, MISC + 8);

    const int gw = vcu * NWAVES + wave, NGW = G * NWAVES;
    const int lo = args.st_lo, hi_ = args.st_hi;
#define IN(k) (lo <= (k) && (k) < hi_)
#define SEAM(k) do { if (IN(k) && IN((k) + 1)) xcd_barrier(bar); } while (0)
    {
        if (IN(0)) for (int rep_ = 0; rep_ < ((DUP_MASK & 1) ? 2 : 1); ++rep_) {
            LAS float* scr = (LAS float*)(lds + wave * 16384);
            constexpr int I_FOLD = 4 * 16 * 8, I_WIN = (DM / 64) * (INW / 32), I_SQ = (DM / 64) * (DM / 32);
            constexpr int NITEMS = I_FOLD + I_WIN + 3 * I_SQ;
            for (int it = gw; it < NITEMS; it += NGW) {
                int r = it;
                if (r < I_FOLD) { p0_fold_item(w_in, w_pg, norm_pre, WIN_T, scr, r, lane); continue; } r -= I_FOLD;
                if (r < I_WIN) { if ((r % (INW / 32)) >= 32) p0_transpose_item<true>(w_in, INW, norm_pre, WIN_T, DM, 0, 0, scr, r, lane); continue; } r -= I_WIN;
                if (r < I_SQ) { p0_transpose_item<false>(w_pp, DM, nullptr, W2_T, 2048, 0, 0, scr, r, lane); continue; } r -= I_SQ;
                if (r < I_SQ) { p0_transpose_item<false>(w_ap, DM, nullptr, W2_T, 2048, 0, 1024, scr, r, lane); continue; } r -= I_SQ;
                p0_transpose_item<false>(w_out, DM, nullptr, WOUT_T, DM, 0, 0, scr, r, lane);
            }
            for (int m = gw; m < NTOK; m += NGW) {
                const float* xrow = (m < CHT ? x_prompt + (size_t)m * DM : x_sample + (size_t)(m - CHT) * DM);
                bf16_t* orow = (bf16_t*)(args.out + (size_t)(m / CHT) * CHT * DM) + (size_t)(m % CHT) * DM;
                const f32x4* xr = (const f32x4*)xrow + lane;
                f32x4 v[4]; float s = 0.f;
#pragma unroll
                for (int j = 0; j < 4; ++j) { v[j] = xr[64 * j]; s += (v[j].x * v[j].x + v[j].y * v[j].y) + (v[j].z * v[j].z + v[j].w * v[j].w); }
                s = wave_sum(s);
                if (lane == 0) RSTD[m] = 1.0f / sqrtf(s * (1.f / DM) + RMS_EPS);
                u32x2* o8 = (u32x2*)orow + lane;
#pragma unroll
                for (int j = 0; j < 4; ++j) { u32x2 w; w.x = cvtpk(v[j].x, v[j].y); w.y = cvtpk(v[j].z, v[j].w); o8[64 * j] = w; }
            }
            for (int e = gw * 64 + lane; e < 8192 * 32; e += NGW * 64) {
                const int i = e & 31, pos = e >> 5;
                const float inv = (float)pow(10000.0, -(double)i / 32.0);
                const float ang = (float)pos * inv;
                ROPEC[e] = (float)cos((double)ang); ROPES[e] = (float)sin((double)ang);
            }
        }
        SEAM(0);
    }
#pragma unroll 1
    for (int c = 0; c < NCHUNK; ++c) {
        const int sb_ = 1 + 5 * c;
        const int S = c == 0 ? 2048 : 8192;
        const float* xc = c == 0 ? x_prompt : x_sample;
        float* yc = args.out + (size_t)c * CHT * DM;
        bf16_t* XB = (bf16_t*)yc;
        const float* rstd_c = RSTD + (size_t)c * CHT;
        if (IN(sb_ + 0)) for (int rep_ = 0; rep_ < ((DUP_MASK & 2) ? 2 : 1); ++rep_) {
            pg8::Gemm g{XB, WIN_T, DM, DM, DM, 0}; pg8::StaticOrder So; So.init(CHT, INW, G, bx);
            pg8::EpiZ E{U, A2, Qb, KT, VT, RHO, GA, rstd_c, pool_scale, ROPEC, ROPES, S, 0};
            pg8::gemm_phase<pg8::EpiZ, pg8::StaticOrder, true, true>(lds, g, So, E);
        }
        SEAM(sb_ + 0);
        if (IN(sb_ + 1)) {
            int ln = lane; asm volatile("" : "+v"(ln));
            for (int rep_ = 0; rep_ < 1; ++rep_)
            for (int it = gw; it < (CHT / 2) * 4; it += NGW) {
                const int g = it & 3, tok = 2 * (it >> 2) + (ln >> 5), cc = g * 256 + (ln & 31) * 8;
                if (g == 0) pool_item<2>(U, A2, tok, cc, S); else if (g == 1) pool_item<4>(U, A2, tok, cc, S); else if (g == 2) pool_item<8>(U, A2, tok, cc, S); else pool_item<16>(U, A2, tok, cc, S);
            }
            const int nqb = S >> 6, nunits = (CHT / S) * 4 * nqb, per = (nunits + G - 1) / G;
            for (int k = 0; k < per; ++k) { const int ui = vcu * per + k; if (ui >= nunits) break;
                const int qb = ui % nqb, hk = (ui / nqb) & 3, sq = ui / (nqb * 4);
                att::attn_unit<4>(lds, sq * S, S, hk, qb, Qb, KT, VT, A2, sink); }
        }
        SEAM(sb_ + 1);
        if (IN(sb_ + 2)) for (int rep_ = 0; rep_ < ((DUP_MASK & 8) ? 2 : 1); ++rep_) {
            pg8::Gemm g{A2, W2_T, 2048, 2048, 2048, 0}; pg8::StaticOrder So; So.init(CHT, DM, G, bx);
            pg8::EpiM E{RHO, GA, Mb};
            pg8::gemm_phase<pg8::EpiM, pg8::StaticOrder, true, true>(lds, g, So, E);
        }
        SEAM(sb_ + 2);
        if (IN(sb_ + 3)) for (int rep_ = 0; rep_ < ((DUP_MASK & 16) ? 2 : 1); ++rep_) {
            pg8::Gemm g{Mb, WOUT_T, DM, DM, DM, 0}; pg8::StaticOrder So; So.init(CHT, DM, G, bx);
            pg8::EpiF32 E{yc, DM, 0};
            pg8::gemm_phase<pg8::EpiF32, pg8::StaticOrder, true, true>(lds, g, So, E);
        }
        SEAM(sb_ + 3);
        if (IN(sb_ + 4)) {
            int ln = lane; asm volatile("" : "+v"(ln));
            for (int m = gw; m < CHT; m += NGW) {
                f32x4* orow = (f32x4*)(yc + (size_t)m * DM) + ln; const f32x4* xr = (const f32x4*)(xc + (size_t)m * DM) + ln;
                f32x4 v[4]; float s = 0.f;
#pragma unroll
                for (int j = 0; j < 4; ++j) { v[j] = orow[64 * j]; s += (v[j].x * v[j].x + v[j].y * v[j].y) + (v[j].z * v[j].z + v[j].w * v[j].w); }
                const float r = 1.0f / sqrtf(wave_sum(s) * (1.f / DM) + RMS_EPS);
#pragma unroll
                for (int j = 0; j < 4; ++j) { const f32x4 gg = ((const f32x4*)norm_post)[ln + 64 * j]; orow[64 * j] = xr[64 * j] + v[j] * r * gg; }
            }
        }
        SEAM(sb_ + 4);
    }
#undef IN
#undef SEAM
}

extern "C" void kernel_launch(void* const* d_in, const int* in_sizes, int n_in, void* d_out, int out_size, void* d_ws, size_t ws_size, hipStream_t stream) {
    static int grid = 0;
    if (grid == 0) {
        if (n_in != 11 || out_size != NTOK * DM || ws_size < WS_END) { fprintf(stderr, "kernel_launch: unexpected shapes / workspace (%d inputs, out %d, ws %zu)\n", n_in, out_size, ws_size); grid = -1; return; }
        int dev = 0, cus = 0, per_cu = 0;
        if (hipGetDevice(&dev) != hipSuccess || hipDeviceGetAttribute(&cus, hipDeviceAttributeMultiprocessorCount, dev) != hipSuccess) { grid = -1; return; }
        if (hipFuncSetAttribute((const void*)mk_fwd, hipFuncAttributeMaxDynamicSharedMemorySize, LDS_BYTES) != hipSuccess) { fprintf(stderr, "kernel_launch: hipFuncSetAttribute failed\n"); grid = -1; return; }
        if (hipOccupancyMaxActiveBlocksPerMultiprocessor(&per_cu, (const void*)mk_fwd, NWAVES * 64, LDS_BYTES) != hipSuccess || per_cu < 1) { fprintf(stderr, "kernel_launch: occupancy query says %d blocks per CU\n", per_cu); grid = -1; (void)hipGetLastError(); return; }
        grid = cus;
    }
    if (grid < 0) return;
    (void)hipMemsetAsync((char*)d_ws + WS_CTL, 0, CTL_ZERO_BYTES, stream);
    Args a{};
    for (int i = 0; i < 11; ++i) a.in[i] = (const float*)d_in[i];
    a.out = (float*)d_out; a.ws = (unsigned char*)d_ws;
    constexpr int NSTEPS = 1 + NCHUNK * 5;
#if MK_MULTI
    for (int s = 0; s < NSTEPS; ++s) { a.st_lo = s; a.st_hi = s + 1; hipLaunchKernelGGL(mk_fwd, dim3(grid), dim3(NWAVES * 64), LDS_BYTES, stream, a); }
#else
    a.st_lo = 0; a.st_hi = NSTEPS;
    hipLaunchKernelGGL(mk_fwd, dim3(grid), dim3(NWAVES * 64), LDS_BYTES, stream, a);
#endif
}
```
